# Optimizing an MI355X kernel written in HIP

```python
import math
import jax, jax.numpy as jnp
from jax import lax
import numpy as np

D_MODEL = 1024
BATCH = 32
SEQ = 2048
DEPTH = 1

CHUNK = 64
Q_BLOCK = 128
HEAD_DIM = 64
MIX_WIDTH = D_MODEL
WIDTH_A = MIX_WIDTH // 2
WIDTH_B = MIX_WIDTH - WIDTH_A
N_HEADS_A = WIDTH_A // HEAD_DIM
N_HEADS_B = WIDTH_B // HEAD_DIM
DIFF_DIM = HEAD_DIM // 2
LEFT_CHUNKS = 8
BAND = (LEFT_CHUNKS + 1) * CHUNK
MAX_REL_DIST = 256
D_FF = 4 * D_MODEL
ROPE_THETA = 10000.0
EPS = 1e-6
QA_COLS = N_HEADS_A * 2 * DIFF_DIM
KA_COLS = N_HEADS_A * 2 * DIFF_DIM
VA_COLS = N_HEADS_A * HEAD_DIM
QB_COLS = N_HEADS_B * HEAD_DIM
KB_COLS = N_HEADS_B * HEAD_DIM
VB_COLS = N_HEADS_B * HEAD_DIM
IN_COLS = QA_COLS + KA_COLS + VA_COLS + QB_COLS + KB_COLS + VB_COLS

kernel_name = "hybrid_diffattn_chunkrel_block"


def rmsnorm(x, g):
    xf = x.astype(jnp.float32)
    y = xf * lax.rsqrt(jnp.mean(xf * xf, axis=-1, keepdims=True) + EPS)
    return y.astype(x.dtype) * g


def rope(x, pos):
    d = x.shape[-1]
    half = d // 2
    inv_freq = ROPE_THETA ** (-jnp.arange(half, dtype=jnp.float32) / half)
    ang = pos.astype(jnp.float32)[:, None] * inv_freq[None, :]
    cos = jnp.cos(ang)[:, None, :]
    sin = jnp.sin(ang)[:, None, :]
    xf = x.astype(jnp.float32)
    x1, x2 = xf[..., :half], xf[..., half:]
    out = jnp.concatenate([x1 * cos - x2 * sin, x2 * cos + x1 * sin], axis=-1)
    return out.astype(x.dtype)


def diff_attention(q, k, v, lam, subln_g, lam_init):
    S = q.shape[1]
    scale = DIFF_DIM ** -0.5
    chunk_id = jnp.arange(S) // CHUNK
    outs = []
    for i in range(S // Q_BLOCK):
        q0, q1 = i * Q_BLOCK, (i + 1) * Q_BLOCK
        qb, kb, vb = q[:, q0:q1], k[:, :q1], v[:, :q1]
        s = jnp.einsum('bqhcd,bkhcd->bhcqk', qb, kb).astype(jnp.float32) * scale
        mask = chunk_id[None, :q1] <= chunk_id[q0:q1, None]
        s = jnp.where(mask, s, -jnp.inf)
        p = jax.nn.softmax(s, axis=-1)
        a = p[:, :, 0] - lam * p[:, :, 1]
        outs.append(jnp.einsum('bhqk,bkhd->bqhd', a.astype(vb.dtype), vb))
    o = jnp.concatenate(outs, axis=1)
    return rmsnorm(o, subln_g) * (1.0 - lam_init)


def chunked_rel_attention(q, k, v, rel_table):
    B, S, H, D = q.shape
    nc = S // CHUNK
    pad = LEFT_CHUNKS * CHUNK
    scale = D ** -0.5
    kp = jnp.pad(k, ((0, 0), (pad, 0), (0, 0), (0, 0)))
    vp = jnp.pad(v, ((0, 0), (pad, 0), (0, 0), (0, 0)))
    q_local = pad + jnp.arange(CHUNK)
    k_local = jnp.arange(BAND)
    dist = jnp.clip(q_local[:, None] - k_local[None, :], -MAX_REL_DIST, MAX_REL_DIST) + MAX_REL_DIST
    bias = rel_table[:, dist].astype(jnp.float32)
    qc = q.reshape(B, nc, CHUNK, H, D).transpose(1, 0, 2, 3, 4)

    def one_chunk(args):
        c, qi = args
        start = c * CHUNK
        kb = lax.dynamic_slice_in_dim(kp, start, BAND, axis=1)
        vb = lax.dynamic_slice_in_dim(vp, start, BAND, axis=1)
        s = jnp.einsum('bqhd,bkhd->bhqk', qi, kb).astype(jnp.float32) * scale + bias
        valid = (start + k_local) >= pad
        s = jnp.where(valid[None, None, None, :], s, -jnp.inf)
        p = jax.nn.softmax(s, axis=-1)
        return jnp.einsum('bhqk,bkhd->bqhd', p.astype(vb.dtype), vb)

    o = lax.map(one_chunk, (jnp.arange(nc), qc))
    return o.transpose(1, 0, 2, 3, 4).reshape(B, S, H, D)


def setup_inputs(seed: int = 0) -> dict:
    key = jax.random.key(seed)
    ks = jax.random.split(key, 16)
    f32 = jnp.float32
    n = lambda k, shape, s: jax.random.normal(k, shape, f32) * s
    return {
        "x": n(ks[0], (BATCH, SEQ, D_MODEL), 1.0),
        "w_in": n(ks[1], (DEPTH, D_MODEL, IN_COLS), D_MODEL ** -0.5),
        "w_out": n(ks[2], (DEPTH, MIX_WIDTH, D_MODEL), MIX_WIDTH ** -0.5),
        "norm1_g": 1.0 + n(ks[3], (DEPTH, D_MODEL), 0.02),
        "norm2_g": 1.0 + n(ks[4], (DEPTH, D_MODEL), 0.02),
        "final_g": 1.0 + n(ks[5], (D_MODEL,), 0.02),
        "subln_g": 1.0 + n(ks[6], (DEPTH, HEAD_DIM), 0.02),
        "lambda_q1": n(ks[7], (DEPTH, DIFF_DIM), 0.1),
        "lambda_k1": n(ks[8], (DEPTH, DIFF_DIM), 0.1),
        "lambda_q2": n(ks[9], (DEPTH, DIFF_DIM), 0.1),
        "lambda_k2": n(ks[10], (DEPTH, DIFF_DIM), 0.1),
        "rel_bias": n(ks[11], (DEPTH, N_HEADS_B, 2 * MAX_REL_DIST + 1), 0.1),
        "w_ff1": n(ks[12], (DEPTH, D_MODEL, D_FF), D_MODEL ** -0.5),
        "w_ff2": n(ks[13], (DEPTH, D_FF, D_MODEL), D_FF ** -0.5),
    }


def reference(x, w_in, w_out, norm1_g, norm2_g, final_g, subln_g, lambda_q1, lambda_k1,
              lambda_q2, lambda_k2, rel_bias, w_ff1, w_ff2):
    B, S, _ = x.shape
    pos = jnp.arange(S)
    splits = np.cumsum([QA_COLS, KA_COLS, VA_COLS, QB_COLS, KB_COLS]).tolist()
    for l in range(DEPTH):
        lam_init = 0.8 - 0.6 * math.exp(-0.3 * l)
        h = rmsnorm(x, norm1_g[l])
        proj = h @ w_in[l]
        qa, ka, va, qb, kb, vb = jnp.split(proj, splits, axis=-1)
        qa = rope(qa.reshape(B, S, N_HEADS_A * 2, DIFF_DIM), pos).reshape(B, S, N_HEADS_A, 2, DIFF_DIM)
        ka = rope(ka.reshape(B, S, N_HEADS_A * 2, DIFF_DIM), pos).reshape(B, S, N_HEADS_A, 2, DIFF_DIM)
        va = va.reshape(B, S, N_HEADS_A, HEAD_DIM)
        lam = (jnp.exp(jnp.sum(lambda_q1[l].astype(jnp.float32) * lambda_k1[l].astype(jnp.float32)))
               - jnp.exp(jnp.sum(lambda_q2[l].astype(jnp.float32) * lambda_k2[l].astype(jnp.float32)))
               + lam_init)
        oa = diff_attention(qa, ka, va, lam, subln_g[l], lam_init)
        qb = qb.reshape(B, S, N_HEADS_B, HEAD_DIM)
        kb = kb.reshape(B, S, N_HEADS_B, HEAD_DIM)
        vb = vb.reshape(B, S, N_HEADS_B, HEAD_DIM)
        ob = chunked_rel_attention(qb, kb, vb, rel_bias[l])
        mix = jnp.concatenate([oa.reshape(B, S, WIDTH_A), ob.reshape(B, S, WIDTH_B)], axis=-1)
        x = x + mix @ w_out[l]
        h = rmsnorm(x, norm2_g[l])
        x = x + jnp.square(jax.nn.relu(h @ w_ff1[l])) @ w_ff2[l]
    return rmsnorm(x, final_g)
```

```cpp
#include <hip/hip_runtime.h>
#include <hip/hip_cooperative_groups.h>
#include <cstdio>
#include <cstdint>
namespace cg = cooperative_groups;
namespace pg8 {
#define PG8_LAS __attribute__((address_space(3)))
typedef unsigned short bf16_t;
typedef short bf16x8 __attribute__((ext_vector_type(8)));
typedef float f32x4 __attribute__((ext_vector_type(4)));
typedef unsigned u32x4 __attribute__((ext_vector_type(4)));
constexpr int BM = 256, BK = 64, HALF = 128, HTB = HALF * BK * 2  , STAGE_BYTES = 8 * HTB, NXCD = 8, WGM = 8;

__host__ __device__ __forceinline__ int lds_byte(int r, int c) { const int st = (r >> 4) * 2 + (c >> 5), rr = r & 15, cc = c & 31, ob = rr * 64 + cc * 2; return st * 1024 + (ob ^ (((ob >> 9) & 1) << 5)); }
__host__ __device__ __forceinline__ void stage_rc(int b, int& R, int& C) { const int st = b / 1024, sb = b % 1024, swz = sb ^ (((sb >> 9) & 1) << 5); R = (st >> 1) * 16 + swz / 64; C = (st & 1) * 32 + (swz % 64) / 2; }
__host__ __device__ __forceinline__ int perm32(int rho) { const int n = rho >> 4, i = rho & 15; return 8 * (i >> 2) + 4 * n + (i & 3); }

struct Unit { int pm, pn; };
struct Gemm { const bf16_t* A; const bf16_t* Bt; int M, N, K; };

struct StaticOrder {
    int nM, nN, nwg, G, c;
    __host__ __device__ void init(int M, int N, int G_, int c_) { nM = M / BM; nN = N / BM; nwg = nM * nN; G = G_; c = c_; }
    __host__ __device__ bool next(int i, Unit& u) const {
        const long L = (long)i * G + c; if (L >= nwg) return false;
        int wgid = (int)L; { const int q = nwg / NXCD, r = nwg % NXCD, xcd = wgid % NXCD, off = wgid / NXCD; wgid = (xcd < r ? xcd * (q + 1) : r * (q + 1) + (xcd - r) * q) + off; }
        const int nig = WGM * nN, gid = wgid / nig, fm = gid * WGM, gsz = (nM - fm) < WGM ? (nM - fm) : WGM;
        u.pm = fm + ((wgid % nig) % gsz); u.pn = (wgid % nig) / gsz; return true;
    }
    __device__ __forceinline__ void a_ready(const Unit&) const {}
    __device__ __forceinline__ void done(const Unit&) const {}
};

__device__ __forceinline__ unsigned cvt_pk_bf16(float lo, float hi) { unsigned r; asm volatile("v_cvt_pk_bf16_f32 %0, %1, %2" : "=v"(r) : "v"(lo), "v"(hi)); return r; }
constexpr float QSCALE_A = 0.17677669529663687f * 1.4426950408889634f;
constexpr float QSCALE_B = 0.125f * 1.4426950408889634f;
struct EpiQKV {
    static constexpr bool PERM = true, AFTER_DRAIN = false;
    bf16_t* O; const float* rope;
    __device__ __forceinline__ void operator()(const f32x4 (&acc)[2][2][4][2], const Unit& u, int wr, int wc, int fr, int fq) const {
        const int row0 = u.pm * BM + wr * 64 + fr, col0 = u.pn * BM + wc * 32 + 8 * fq;
        const bool do_rope = u.pn < 4;
        const float qs = (u.pn < 2) ? QSCALE_A : ((u.pn == 6 || u.pn == 7) ? QSCALE_B : 1.f);
        const float sgn = (fq < 2) ? -1.f : 1.f;
#pragma unroll
        for (int ai = 0; ai < 2; ++ai)
#pragma unroll
            for (int m = 0; m < 4; ++m) {
                const int row = row0 + ai * HALF + m * 16;
                f32x4 v[2][2];
#pragma unroll
                for (int bj = 0; bj < 2; ++bj)
#pragma unroll
                    for (int n = 0; n < 2; ++n) v[bj][n] = acc[ai][bj][m][n];
                if (do_rope) {
                    const int pos = row & 2047;
                    const f32x4* rp = (const f32x4*)(rope + (size_t)(pos * 16 + 8 * (fq & 1)) * 2);
                    const f32x4 cs0 = rp[0], cs1 = rp[1], cs2 = rp[2], cs3 = rp[3];
                    const f32x4 c0 = {cs0[0], cs0[2], cs1[0], cs1[2]}, s0 = {cs0[1], cs0[3], cs1[1], cs1[3]};
                    const f32x4 c1 = {cs2[0], cs2[2], cs3[0], cs3[2]}, s1 = {cs2[1], cs2[3], cs3[1], cs3[3]};
#pragma unroll
                    for (int bj = 0; bj < 2; ++bj)
#pragma unroll
                        for (int n = 0; n < 2; ++n) {
                            const f32x4 x = v[bj][n]; f32x4 xp;
                            xp[0] = __shfl_xor(x[0], 32); xp[1] = __shfl_xor(x[1], 32); xp[2] = __shfl_xor(x[2], 32); xp[3] = __shfl_xor(x[3], 32);
                            const f32x4 c = n ? c1 : c0, s = n ? s1 : s0;
                            v[bj][n] = x * c + (xp * s) * sgn;
                        }
                }
                bf16_t* rowp = O + (size_t)row * 3072 + col0;
#pragma unroll
                for (int bj = 0; bj < 2; ++bj) { const f32x4 v0 = v[bj][0] * qs, v1 = v[bj][1] * qs;
                    u32x4 w; w.x = cvt_pk_bf16(v0[0], v0[1]); w.y = cvt_pk_bf16(v0[2], v0[3]); w.z = cvt_pk_bf16(v1[0], v1[1]); w.w = cvt_pk_bf16(v1[2], v1[3]);
                    *(u32x4*)(rowp + bj * HALF) = w; }
            }
    }
};
struct EpiResid {
    static constexpr bool PERM = true, AFTER_DRAIN = false;
    const float* base; float* out; bf16_t* ob; float* ss;
    __device__ __forceinline__ void operator()(const f32x4 (&acc)[2][2][4][2], const Unit& u, int wr, int wc, int fr, int fq) const {
        const int row0 = u.pm * BM + wr * 64 + fr, col0 = u.pn * BM + wc * 32 + 8 * fq;
#pragma unroll
        for (int ai = 0; ai < 2; ++ai)
#pragma unroll
            for (int m = 0; m < 4; ++m) {
                const int row = row0 + ai * HALF + m * 16; const size_t off = (size_t)row * 1024 + col0;
                float s = 0.f;
#pragma unroll
                for (int bj = 0; bj < 2; ++bj) {
                    const f32x4 b0 = *(const f32x4*)(base + off + bj * HALF), b1 = *(const f32x4*)(base + off + bj * HALF + 4);
                    const f32x4 v0 = acc[ai][bj][m][0] + b0, v1 = acc[ai][bj][m][1] + b1;
                    *(f32x4*)(out + off + bj * HALF) = v0; *(f32x4*)(out + off + bj * HALF + 4) = v1;
                    if (ob) { u32x4 w; w.x = cvt_pk_bf16(v0[0], v0[1]); w.y = cvt_pk_bf16(v0[2], v0[3]); w.z = cvt_pk_bf16(v1[0], v1[1]); w.w = cvt_pk_bf16(v1[2], v1[3]);
                        *(u32x4*)(ob + off + bj * HALF) = w; }
                    s += (v0[0] * v0[0] + v0[1] * v0[1]) + (v0[2] * v0[2] + v0[3] * v0[3]) + (v1[0] * v1[0] + v1[1] * v1[1]) + (v1[2] * v1[2] + v1[3] * v1[3]);
                }
                s += __shfl_xor(s, 16); s += __shfl_xor(s, 32);
                if (fq == 0) ss[(size_t)row * 16 + u.pn * 4 + wc] = s;
                asm volatile("" ::: "memory");
            }
    }
};
struct EpiUp {
    static constexpr bool PERM = true, AFTER_DRAIN = false;
    bf16_t* O; const float* ss;
    __device__ __forceinline__ void operator()(const f32x4 (&acc)[2][2][4][2], const Unit& u, int wr, int wc, int fr, int fq) const {
        const int row0 = u.pm * BM + wr * 64 + fr, col0 = u.pn * BM + wc * 32 + 8 * fq;
#pragma unroll
        for (int ai = 0; ai < 2; ++ai)
#pragma unroll
            for (int m = 0; m < 4; ++m) {
                const int row = row0 + ai * HALF + m * 16;
                const f32x4* sp = (const f32x4*)(ss + (size_t)row * 16);
                const f32x4 a = sp[0], b = sp[1], c = sp[2], d = sp[3];
                const float tot = ((a[0] + a[1]) + (a[2] + a[3])) + ((b[0] + b[1]) + (b[2] + b[3])) + ((c[0] + c[1]) + (c[2] + c[3])) + ((d[0] + d[1]) + (d[2] + d[3]));
                const float r = 1.0f / sqrtf(tot * (1.0f / 1024.0f) + 1e-6f);
                bf16_t* rowp = O + (size_t)row * 4096 + col0;
#pragma unroll
                for (int bj = 0; bj < 2; ++bj) {
                    f32x4 v0 = acc[ai][bj][m][0] * r, v1 = acc[ai][bj][m][1] * r;
#pragma unroll
                    for (int e = 0; e < 4; ++e) { v0[e] = fmaxf(v0[e], 0.f); v1[e] = fmaxf(v1[e], 0.f); }
                    v0 = v0 * v0; v1 = v1 * v1;
                    u32x4 w; w.x = cvt_pk_bf16(v0[0], v0[1]); w.y = cvt_pk_bf16(v0[2], v0[3]); w.z = cvt_pk_bf16(v1[0], v1[1]); w.w = cvt_pk_bf16(v1[2], v1[3]);
                    *(u32x4*)(rowp + bj * HALF) = w;
                }
            }
    }
};

template <class Epi, class Sched, bool ALIGN_EPI = false, bool SP2 = false>
__device__ __forceinline__ void gemm_phase(PG8_LAS unsigned char* lds, const Gemm g, const Sched& S, const Epi& E) {
    int tid_ = threadIdx.x; asm volatile("" : "+v"(tid_));
    const int tid = tid_, wid = __builtin_amdgcn_readfirstlane(tid >> 6), lane = tid & 63, wr = wid >> 2, wc = wid & 3, fr = lane & 15, fq = lane >> 4;
    const int K = g.K, nt = K / BK;
    unsigned voffA[2], voffB[2];
#pragma unroll
    for (int i = 0; i < 2; ++i) { int R, C; stage_rc(tid * 16 + i * 8192, R, C); const int Rb = Epi::PERM ? ((R & ~31) + perm32(R & 31)) : R;
        voffA[i] = (unsigned)(R * K + C) * 2u; voffB[i] = (unsigned)(Rb * K + C) * 2u; }
    const size_t kstep = (size_t)(BK * 2);
    const size_t hstep = (size_t)HALF * K * 2;
    const size_t tstep = 2 * hstep;
    const unsigned ldsw = (unsigned)wid * 1024u;
    const int aoff = lds_byte(wr * 64 + fr, fq * 8), boff = lds_byte(wc * 32 + fr, fq * 8);
#define PG8_SA(b, h) (((b) * 2 + (h)) * HTB)
#define PG8_SB(b, h) ((4 + (b) * 2 + (h)) * HTB)
#define PG8_STAGE(bufoff, gbase, voff) do { _Pragma("unroll") for (int _i = 0; _i < 2; ++_i) \
        __builtin_amdgcn_global_load_lds((const unsigned*)((const char*)(gbase) + (voff)[_i]), (PG8_LAS unsigned*)(lds + (bufoff) + ldsw + _i * 8192), 16, 0, 0); } while (0)
#define PG8_LDA(dst, b, h) do { _Pragma("unroll") for (int m = 0; m < 4; ++m) _Pragma("unroll") for (int k = 0; k < 2; ++k) dst[m][k] = *(const PG8_LAS bf16x8*)(lds + PG8_SA(b, h) + aoff + m * 2048 + k * 1024); } while (0)
#define PG8_LDB(dst, b, h) do { _Pragma("unroll") for (int n = 0; n < 2; ++n) _Pragma("unroll") for (int k = 0; k < 2; ++k) dst[n][k] = *(const PG8_LAS bf16x8*)(lds + PG8_SB(b, h) + boff + n * 2048 + k * 1024); } while (0)
#define PG8_MMA(ai, bj, At, Bt) do { __builtin_amdgcn_s_setprio(1); _Pragma("unroll") for (int m = 0; m < 4; ++m) _Pragma("unroll") for (int n = 0; n < 2; ++n) _Pragma("unroll") for (int k = 0; k < 2; ++k) \
        acc[ai][bj][m][n] = __builtin_amdgcn_mfma_f32_16x16x32_bf16(Bt[n][k], At[m][k], acc[ai][bj][m][n], 0, 0, 0); __builtin_amdgcn_s_setprio(0); } while (0)
#define PG8_WAIT_V(n) asm volatile("s_waitcnt vmcnt(" #n ")" ::: "memory")
#define PG8_WAIT_L(n) asm volatile("s_waitcnt lgkmcnt(" #n ")" ::: "memory")
#define PG8_BAR __builtin_amdgcn_s_barrier()
#define PG8_SCHED __builtin_amdgcn_sched_barrier(0)
    Unit cur, nxt; int ui = 0;
    if (!S.next(0, cur)) return;
    f32x4 acc[2][2][4][2];
#pragma unroll
    for (int a = 0; a < 2; ++a)
#pragma unroll
        for (int b = 0; b < 2; ++b)
#pragma unroll
            for (int m = 0; m < 4; ++m)
#pragma unroll
                for (int n = 0; n < 2; ++n) acc[a][b][m][n] = (f32x4){0.f, 0.f, 0.f, 0.f};
    bf16x8 At[4][2], B0[2][2], B1[2][2];
    const char* cA = (const char*)g.A + (size_t)cur.pm * tstep; const char* cB = (const char*)g.Bt + (size_t)cur.pn * tstep;
    S.a_ready(cur);
    if constexpr (SP2) {
        PG8_STAGE(PG8_SB(0, 0), cB, voffB); PG8_STAGE(PG8_SB(0, 1), cB + hstep, voffB); PG8_STAGE(PG8_SA(0, 0), cA, voffA); PG8_STAGE(PG8_SA(0, 1), cA + hstep, voffA);
        if (wr == 1) PG8_BAR;
        PG8_WAIT_V(2); PG8_BAR;
        PG8_STAGE(PG8_SB(1, 0), cB + kstep, voffB); PG8_STAGE(PG8_SA(1, 0), cA + kstep, voffA); PG8_STAGE(PG8_SB(1, 1), cB + hstep + kstep, voffB);
        PG8_WAIT_V(6); PG8_BAR;
    } else {
        PG8_STAGE(PG8_SB(0, 0), cB, voffB); PG8_STAGE(PG8_SA(0, 0), cA, voffA); PG8_STAGE(PG8_SB(0, 1), cB + hstep, voffB); PG8_STAGE(PG8_SA(0, 1), cA + hstep, voffA);
        if (wr == 1) PG8_BAR;
        PG8_WAIT_V(4); PG8_BAR;
        PG8_STAGE(PG8_SB(1, 0), cB + kstep, voffB); PG8_STAGE(PG8_SA(1, 0), cA + kstep, voffA); PG8_STAGE(PG8_SB(1, 1), cB + hstep + kstep, voffB);
        PG8_WAIT_V(6); PG8_BAR;
    }
    for (;;) {
        const bool has_next = S.next(ui + 1, nxt);
        const char* nA = has_next ? (const char*)g.A + (size_t)nxt.pm * tstep : cA; const char* nB = has_next ? (const char*)g.Bt + (size_t)nxt.pn * tstep : cB;
        for (int t = 0; t < nt; t += 2) {
            const bool last = (t == nt - 2);
            const char* a1 = cA + (size_t)(t + 1) * kstep;
            const char* a2 = last ? nA : cA + (size_t)(t + 2) * kstep; const char* b2 = last ? nB : cB + (size_t)(t + 2) * kstep;
            const char* a3 = a2 + kstep; const char* b3 = b2 + kstep;
            if (last && has_next) S.a_ready(nxt);
            if constexpr (SP2) {
            PG8_LDB(B0, 0, 0); PG8_LDB(B1, 0, 1); PG8_SCHED; PG8_LDA(At, 0, 0); PG8_STAGE(PG8_SA(1, 1), a1 + hstep, voffA);
            PG8_WAIT_V(8); PG8_WAIT_L(0); PG8_BAR; PG8_MMA(0, 0, At, B0); PG8_MMA(0, 1, At, B1); PG8_BAR; PG8_SCHED;
            PG8_LDA(At, 0, 1); PG8_STAGE(PG8_SB(0, 0), b2, voffB); PG8_STAGE(PG8_SB(0, 1), b2 + hstep, voffB); PG8_STAGE(PG8_SA(0, 0), a2, voffA);
            PG8_WAIT_V(8); PG8_WAIT_L(0); PG8_BAR; PG8_MMA(1, 0, At, B0); PG8_MMA(1, 1, At, B1); PG8_BAR; PG8_SCHED;
            PG8_LDB(B0, 1, 0); PG8_LDB(B1, 1, 1); PG8_SCHED; PG8_LDA(At, 1, 0); PG8_STAGE(PG8_SA(0, 1), a2 + hstep, voffA);
            PG8_WAIT_V(8); PG8_WAIT_L(0); PG8_BAR; PG8_MMA(0, 0, At, B0); PG8_MMA(0, 1, At, B1); PG8_BAR; PG8_SCHED;
            PG8_LDA(At, 1, 1); PG8_STAGE(PG8_SB(1, 0), b3, voffB); PG8_STAGE(PG8_SB(1, 1), b3 + hstep, voffB); PG8_STAGE(PG8_SA(1, 0), a3, voffA);
            PG8_WAIT_V(8); PG8_WAIT_L(0); PG8_BAR; PG8_MMA(1, 0, At, B0); PG8_MMA(1, 1, At, B1); PG8_BAR; PG8_SCHED;
            } else {
            PG8_LDB(B0, 0, 0); PG8_SCHED; PG8_LDA(At, 0, 0); PG8_STAGE(PG8_SA(1, 1), a1 + hstep, voffA);
            PG8_WAIT_L(8); PG8_BAR; PG8_WAIT_L(0); PG8_MMA(0, 0, At, B0); PG8_BAR; PG8_SCHED;
            PG8_LDB(B1, 0, 1); PG8_STAGE(PG8_SB(0, 0), b2, voffB);
            PG8_BAR; PG8_WAIT_L(0); PG8_MMA(0, 1, At, B1); PG8_BAR;
            PG8_LDA(At, 0, 1); PG8_STAGE(PG8_SA(0, 0), a2, voffA);
            PG8_BAR; PG8_WAIT_L(0); PG8_MMA(1, 0, At, B0); PG8_BAR; PG8_SCHED;
            PG8_STAGE(PG8_SB(0, 1), b2 + hstep, voffB);
            PG8_WAIT_V(6); PG8_BAR; PG8_MMA(1, 1, At, B1); PG8_BAR;
            PG8_LDB(B0, 1, 0); PG8_SCHED; PG8_LDA(At, 1, 0); PG8_STAGE(PG8_SA(0, 1), a2 + hstep, voffA);
            PG8_WAIT_L(8); PG8_BAR; PG8_WAIT_L(0); PG8_MMA(0, 0, At, B0); PG8_BAR; PG8_SCHED;
            PG8_LDB(B1, 1, 1); PG8_STAGE(PG8_SB(1, 0), b3, voffB);
            PG8_BAR; PG8_WAIT_L(0); PG8_MMA(0, 1, At, B1); PG8_BAR;
            PG8_LDA(At, 1, 1); PG8_STAGE(PG8_SA(1, 0), a3, voffA);
            PG8_BAR; PG8_WAIT_L(0); PG8_MMA(1, 0, At, B0); PG8_BAR; PG8_SCHED;
            PG8_STAGE(PG8_SB(1, 1), b3 + hstep, voffB);
            PG8_WAIT_V(6); PG8_BAR; PG8_MMA(1, 1, At, B1); PG8_BAR;
            }
        }
        if constexpr (ALIGN_EPI) { if (wr == 0) PG8_BAR; }
        if constexpr (!Epi::AFTER_DRAIN) { E(acc, cur, wr, wc, fr, fq); S.done(cur); }
        if (!has_next) break;
#pragma unroll
        for (int a = 0; a < 2; ++a)
#pragma unroll
            for (int b = 0; b < 2; ++b)
#pragma unroll
                for (int m = 0; m < 4; ++m)
#pragma unroll
                    for (int n = 0; n < 2; ++n) acc[a][b][m][n] = (f32x4){0.f, 0.f, 0.f, 0.f};
        cur = nxt; cA = nA; cB = nB; ++ui;
        if constexpr (ALIGN_EPI) { if (wr == 1) PG8_BAR; }
    }
    PG8_WAIT_V(0);
    if constexpr (!ALIGN_EPI) { if (wr == 0) PG8_BAR; }
    PG8_BAR;
    if constexpr (Epi::AFTER_DRAIN) { E.fused(acc, cur, wr, wc, fr, fq, lds, wid, lane); S.done(cur); }
#undef PG8_SA
#undef PG8_SB
#undef PG8_STAGE
#undef PG8_LDA
#undef PG8_LDB
#undef PG8_MMA
#undef PG8_WAIT_V
#undef PG8_WAIT_L
#undef PG8_BAR
#undef PG8_SCHED
}
}
namespace att {
#define ALAS __attribute__((address_space(3)))
typedef unsigned short bf16;
typedef short bf16x8 __attribute__((ext_vector_type(8)));
typedef short s16x4 __attribute__((ext_vector_type(4)));
typedef float f32x16 __attribute__((ext_vector_type(16)));
typedef unsigned u32x4 __attribute__((ext_vector_type(4)));
constexpr int SEQ = 2048, PITCH = 3072, MIXP = 1024;
constexpr int STAGE = 32768;
constexpr int LDS_WS = 2 * STAGE, LDS_OST = LDS_WS + 8 * 512, LDS_BIAS = LDS_OST + 8 * 4096, LDS_END = LDS_BIAS + 768 * 4;
constexpr float THR = 8.0f;
__device__ __forceinline__ int crow(int r, int hi) { return (r & 3) + 8 * (r >> 2) + 4 * hi; }
__device__ __forceinline__ void glds16(const void* gsrc, unsigned lds_dst) { unsigned keep;
    asm volatile("s_mov_b32 %0, m0\n\ts_mov_b32 m0, %2\n\ts_nop 0\n\tglobal_load_lds_dwordx4 %1, off\n\ts_mov_b32 m0, %0" : "=&s"(keep) : "v"(gsrc), "s"(lds_dst) : "memory"); }
typedef float f32x2_t __attribute__((ext_vector_type(2))); typedef __bf16 bf16x2_t __attribute__((ext_vector_type(2)));
__device__ __forceinline__ unsigned cvtpk(float lo, float hi) { f32x2_t v = {lo, hi}; bf16x2_t b = __builtin_convertvector(v, bf16x2_t); return __builtin_bit_cast(unsigned, b); }
#define MX3(a, b, c) __builtin_fmaxf(__builtin_fmaxf((a), (b)), (c))
__device__ __forceinline__ float rowmax(const f32x16& p0, const f32x16& p1) {
    float a = MX3(p0[0], p0[1], p1[0]), b = MX3(p0[2], p0[3], p1[1]); a = MX3(a, p1[2], p1[3]);
#pragma unroll
    for (int r = 4; r < 16; r += 4) { a = MX3(a, p0[r], p0[r + 1]); b = MX3(b, p0[r + 2], p0[r + 3]); a = MX3(a, p1[r], p1[r + 1]); b = MX3(b, p1[r + 2], p1[r + 3]); }
    float rm = __builtin_fmaxf(a, b);
    auto rr = __builtin_amdgcn_permlane32_swap(__float_as_uint(rm), __float_as_uint(rm), false, false);
    return __builtin_fmaxf(__uint_as_float(rr[0]), __uint_as_float(rr[1]));
}
__device__ __forceinline__ void pv(f32x16* o, int vb, bf16x8 pa0, bf16x8 pa1, bf16x8 pa2, bf16x8 pa3) {
#pragma unroll
    for (int d0 = 0; d0 < 2; ++d0) { s16x4 lo[4], hi[4];
#pragma unroll
        for (int ks = 0; ks < 4; ++ks) {
            asm volatile("ds_read_b64_tr_b16 %0,%1 offset:%c2" : "=&v"(lo[ks]) : "v"(vb), "i"(d0 * 4096 + ks * 1024) : "memory");
            asm volatile("ds_read_b64_tr_b16 %0,%1 offset:%c2" : "=&v"(hi[ks]) : "v"(vb), "i"(d0 * 4096 + ks * 1024 + 512) : "memory"); }
        asm volatile("s_waitcnt lgkmcnt(0)" ::: "memory"); __builtin_amdgcn_sched_barrier(0);
#define PK(k) (bf16x8){lo[k][0], lo[k][1], lo[k][2], lo[k][3], hi[k][0], hi[k][1], hi[k][2], hi[k][3]}
        o[d0] = __builtin_amdgcn_mfma_f32_32x32x16_bf16(pa0, PK(0), o[d0], 0, 0, 0);
        o[d0] = __builtin_amdgcn_mfma_f32_32x32x16_bf16(pa1, PK(1), o[d0], 0, 0, 0);
        o[d0] = __builtin_amdgcn_mfma_f32_32x32x16_bf16(pa2, PK(2), o[d0], 0, 0, 0);
        o[d0] = __builtin_amdgcn_mfma_f32_32x32x16_bf16(pa3, PK(3), o[d0], 0, 0, 0);
#undef PK
    }
}
#define LWAIT() asm volatile("s_waitcnt lgkmcnt(0)" ::: "memory")

template <bool DIFF>
__device__ __forceinline__ void attn_unit(int b, int hp, int cp, const bf16* __restrict__ PROJ, bf16* __restrict__ MIX, ALAS unsigned char* shm,
                                          float lam, const float* __restrict__ subg, const float* __restrict__ BT) {
    constexpr int NM = DIFF ? 2 : 1;
    int tid_ = threadIdx.x; asm volatile("" : "+v"(tid_));
    const int tid = tid_, lane = tid & 63, r32 = lane & 31, hi = lane >> 5; const int wid = __builtin_amdgcn_readfirstlane(tid >> 6);
    const int hsel = wid >> 2, csel = (wid >> 1) & 1, half = wid & 1;
    const int h = 2 * hp + hsel, chunk = 2 * cp + csel;
    const long rowbase = (long)b * SEQ;
    const int colQ = (DIFF ? 0 : 1536) + h * 64, colK0 = (DIFF ? 512 : 2048) + hp * 128, colV0 = (DIFF ? 1024 : 2560) + hp * 128;
    const int t_lo = DIFF ? 0 : (2 * cp - 8 > 0 ? 2 * cp - 8 : 0), t_hi = 2 * cp + 1;
    const int my_lo = DIFF ? 0 : (chunk - 8 > 0 ? chunk - 8 : 0), my_hi = chunk;
    const unsigned lds0 = (unsigned)(uintptr_t)shm;
    const bf16* ksrc = PROJ + (rowbase + lane) * PITCH + colK0 + wid * 8;
    const bf16* vsrc = PROJ + (rowbase + 16 * (wid & 3) + (lane >> 2)) * PITCH + colV0 + (wid >> 2) * 32 + (lane & 3) * 8;
    const unsigned kdst = lds0 + wid * 1024, vdst = lds0 + 8192 + wid * 1024;
#define RFL(x) ((unsigned)__builtin_amdgcn_readfirstlane((int)(x)))
#define DMA_TILE(t, st) do { const long o_ = (long)(t) * 64 * PITCH; const unsigned s_ = (unsigned)(st) * STAGE; \
        glds16(ksrc + o_, RFL(kdst + s_)); glds16(ksrc + o_ + 64, RFL(kdst + s_ + 16384)); glds16(vsrc + o_, RFL(vdst + s_)); glds16(vsrc + o_ + 64, RFL(vdst + s_ + 16384)); } while (0)
    ALAS float* wsf = (ALAS float*)(shm + LDS_WS) + wid * 128;
    ALAS float* bl = (ALAS float*)(shm + LDS_BIAS);
    float bfar = 0.f;
    if (!DIFF) { for (int i = tid; i < 768; i += 512) bl[i] = BT[(2 * hp) * 384 + i]; bfar = BT[h * 384 + 383]; }
    DMA_TILE(t_lo, 0);
    const bf16* Qw = PROJ + (rowbase + chunk * 64 + half * 32 + r32) * PITCH + colQ;
    bf16x8 qr[4];
#pragma unroll
    for (int d0 = 0; d0 < 4; ++d0) qr[d0] = *(const bf16x8*)(Qw + d0 * 16 + hi * 8);
    float mhat[NM], lsum[NM]; f32x16 o[NM][2];
#pragma unroll
    for (int mp = 0; mp < NM; ++mp) { mhat[mp] = 0.f; lsum[mp] = 0.f; o[mp][0] = f32x16{}; o[mp][1] = f32x16{}; }
    bool first = true;
    for (int t = t_lo; t <= t_hi; ++t) {
        const int st = (t - t_lo) & 1;
        asm volatile("s_waitcnt vmcnt(0) lgkmcnt(0)\n\ts_barrier" ::: "memory");
        if (t < t_hi) DMA_TILE(t + 1, st ^ 1);
        if (t >= my_lo && t <= my_hi) {
            const ALAS unsigned char* kb = shm + st * STAGE + hsel * 16384 + hi * 1024 + r32 * 16;
            const int vb = (int)(lds0 + st * STAGE + hsel * 16384 + 8192) + ((lane >> 4) & 1) * 32 + (lane & 3) * 8 + (4 * hi + ((lane & 15) >> 2)) * 64;
#pragma unroll
            for (int mp = 0; mp < NM; ++mp) {
                f32x16 p0 = f32x16{}, p1 = f32x16{};
#pragma unroll
                for (int dd = 0; dd < (DIFF ? 2 : 4); ++dd) { const int d0 = DIFF ? (mp * 2 + dd) : dd;
                    const bf16x8 b0 = *(const ALAS bf16x8*)(kb + d0 * 2048), b1 = *(const ALAS bf16x8*)(kb + d0 * 2048 + 512);
                    p0 = __builtin_amdgcn_mfma_f32_32x32x16_bf16(b0, qr[d0], p0, 0, 0, 0); p1 = __builtin_amdgcn_mfma_f32_32x32x16_bf16(b1, qr[d0], p1, 0, 0, 0); }
                if (!DIFF) {
                    const int dch = chunk - t;
                    if (dch <= 4) { const ALAS float* bp = bl + hsel * 384 + 63 + 64 * dch + half * 32 + r32 - 4 * hi;
#pragma unroll
                        for (int r = 0; r < 16; ++r) { const int cr = (r & 3) + 8 * (r >> 2); p0[r] += bp[-cr]; p1[r] += bp[-cr - 32]; } }
                    else {
#pragma unroll
                        for (int r = 0; r < 16; ++r) { p0[r] += bfar; p1[r] += bfar; } }
                }
                const float rm = rowmax(p0, p1) - mhat[mp];
                const bool trig = first || (__any(rm > THR) != 0);
                if (trig) {
                    const float dl = first ? rm : __builtin_fmaxf(rm, 0.f);
                    mhat[mp] += dl;
                    if (!first) { const float f = __builtin_amdgcn_exp2f(-dl); lsum[mp] *= f; if (hi == 0) wsf[r32] = f; LWAIT();
#pragma unroll
                        for (int r = 0; r < 16; ++r) { const float fr_ = wsf[crow(r, hi)]; o[mp][0][r] *= fr_; o[mp][1][r] *= fr_; }
                        LWAIT(); }
                }
                const float mh = mhat[mp]; float sacc = 0.f;
#pragma unroll
                for (int r = 0; r < 16; ++r) { p0[r] = __builtin_amdgcn_exp2f(p0[r] - mh); p1[r] = __builtin_amdgcn_exp2f(p1[r] - mh); sacc += p0[r] + p1[r]; }
                lsum[mp] += sacc;
                u32x4 pw0 = {cvtpk(p0[0], p0[1]), cvtpk(p0[2], p0[3]), cvtpk(p0[4], p0[5]), cvtpk(p0[6], p0[7])};
                u32x4 pw1 = {cvtpk(p0[8], p0[9]), cvtpk(p0[10], p0[11]), cvtpk(p0[12], p0[13]), cvtpk(p0[14], p0[15])};
                u32x4 pw2 = {cvtpk(p1[0], p1[1]), cvtpk(p1[2], p1[3]), cvtpk(p1[4], p1[5]), cvtpk(p1[6], p1[7])};
                u32x4 pw3 = {cvtpk(p1[8], p1[9]), cvtpk(p1[10], p1[11]), cvtpk(p1[12], p1[13]), cvtpk(p1[14], p1[15])};
                pv(o[mp], vb, __builtin_bit_cast(bf16x8, pw0), __builtin_bit_cast(bf16x8, pw1), __builtin_bit_cast(bf16x8, pw2), __builtin_bit_cast(bf16x8, pw3));
            }
            first = false;
        }
    }
#pragma unroll
    for (int mp = 0; mp < NM; ++mp) { auto rr = __builtin_amdgcn_permlane32_swap(__float_as_uint(lsum[mp]), __float_as_uint(lsum[mp]), false, false);
        const float l = __uint_as_float(rr[0]) + __uint_as_float(rr[1]); if (hi == 0) wsf[32 + 32 * mp + r32] = 1.0f / l; }
    LWAIT();
    f32x16 of[2];
#pragma unroll
    for (int r = 0; r < 16; ++r) { const float rl0 = wsf[32 + crow(r, hi)];
        if (DIFF) { const float rl1 = wsf[64 + crow(r, hi)] * lam; of[0][r] = o[0][0][r] * rl0 - o[NM - 1][0][r] * rl1; of[1][r] = o[0][1][r] * rl0 - o[NM - 1][1][r] * rl1; }
        else { of[0][r] = o[0][0][r] * rl0; of[1][r] = o[0][1][r] * rl0; } }
    if (DIFF) {
        const float g0 = subg[r32], g1 = subg[32 + r32];
#pragma unroll
        for (int r = 0; r < 16; ++r) { float ss = of[0][r] * of[0][r] + of[1][r] * of[1][r];
            ss += __shfl_xor(ss, 1); ss += __shfl_xor(ss, 2); ss += __shfl_xor(ss, 4); ss += __shfl_xor(ss, 8); ss += __shfl_xor(ss, 16);
            const float sc = 0.8f / sqrtf(ss * (1.0f / 64.0f) + 1e-6f);
            of[0][r] *= sc * g0; of[1][r] *= sc * g1; }
    }
    { ALAS bf16* stg = (ALAS bf16*)(shm + LDS_OST) + wid * 2048;
#pragma unroll
        for (int r = 0; r < 16; ++r) { const int orow = crow(r, hi);
            stg[orow * 64 + r32] = (bf16)(cvtpk(of[0][r], 0.f) & 0xffffu); stg[orow * 64 + 32 + r32] = (bf16)(cvtpk(of[1][r], 0.f) & 0xffffu); }
        LWAIT();
        bf16* Ow = MIX + (rowbase + chunk * 64 + half * 32) * MIXP + (DIFF ? 0 : 512) + h * 64;
#pragma unroll
        for (int i = 0; i < 4; ++i) { const int row = i * 8 + (lane >> 3), ch = lane & 7; const u32x4 v = *(const ALAS u32x4*)(stg + row * 64 + ch * 8); *(u32x4*)(Ow + (long)row * MIXP + ch * 8) = v; } }
    asm volatile("s_waitcnt lgkmcnt(0)\n\ts_barrier" ::: "memory");
#undef DMA_TILE
#undef RFL
}
#undef MX3
#undef LWAIT
}

constexpr int NWAVES = 8;
constexpr int BATCH = 32, SEQ = 2048, D = 1024, FF = 4096, NIN = 3072;
constexpr int M = BATCH * SEQ;
constexpr float EPS = 1e-6f;
constexpr size_t MiB = 1u << 20;
constexpr size_t WS_ROPE = 1 * MiB, WS_BT = 1 * MiB + 512 * 1024;
constexpr size_t WS_WIN = 2 * MiB, WS_WO = 8 * MiB, WS_W1 = 10 * MiB, WS_W2 = 18 * MiB;
constexpr size_t WS_SS2 = 28 * MiB, WS_SS3 = 32 * MiB;
constexpr size_t WS_XB = 64 * MiB;
constexpr size_t WS_PROJ = 192 * MiB, WS_MIX = 576 * MiB, WS_H = 192 * MiB, WS_END = 704 * MiB;
constexpr int LDS_BYTES = 147456;
static_assert(att::LDS_END <= 131072 && pg8::STAGE_BYTES <= 131072, "LDS map");

#define GAS __attribute__((address_space(1)))
#define LAS __attribute__((address_space(3)))
typedef unsigned short bf16;
typedef unsigned v4u __attribute__((ext_vector_type(4)));
typedef float f32x4 __attribute__((ext_vector_type(4)));
__device__ __forceinline__ unsigned f2bf(float f) { unsigned u = __builtin_bit_cast(unsigned, f); return (u + 0x7fffu + ((u >> 16) & 1u)) >> 16; }
__device__ __forceinline__ unsigned pk2(float lo, float hi) { return f2bf(lo) | (f2bf(hi) << 16); }
__device__ __forceinline__ float wave_sum(float v) {
#pragma unroll
    for (int o = 1; o < 64; o <<= 1) v += __shfl_xor(v, o);
    return v;
}
__device__ __forceinline__ void p0_transpose_item(const float* W, const float* gain, int K, int N, bf16* WT, LAS float* scr, int item, int lane) {
    const int nblk = N / 32, kb = item / nblk, nb = item % nblk, k0 = 64 * kb, n0 = 32 * nb;
#pragma unroll 8
    for (int i = 0; i < 32; ++i) { const int kk = 2 * i + (lane >> 5); const float g = gain ? gain[k0 + kk] : 1.f; scr[kk * 33 + (lane & 31)] = W[(size_t)(k0 + kk) * N + n0 + (lane & 31)] * g; }
    asm volatile("s_waitcnt lgkmcnt(0)" ::: "memory");
    const int c = lane & 7;
#pragma unroll
    for (int j = 0; j < 4; ++j) { const int n = (lane >> 3) + 8 * j; const LAS float* s = scr + (8 * c) * 33 + n;
        v4u o; o.x = pk2(s[0 * 33], s[1 * 33]); o.y = pk2(s[2 * 33], s[3 * 33]); o.z = pk2(s[4 * 33], s[5 * 33]); o.w = pk2(s[6 * 33], s[7 * 33]);
        *(v4u*)(WT + (size_t)(n0 + n) * K + k0 + 8 * c) = o; }
    asm volatile("s_waitcnt lgkmcnt(0)" ::: "memory");
}

struct Args { const float* in[14]; float* out; unsigned char* ws; };
#ifndef PH_LIMIT
#define PH_LIMIT 7
#endif
__global__ void __launch_bounds__(NWAVES * 64, 2) mk_fwd(Args args) {
    extern __shared__ __attribute__((aligned(16))) unsigned char lds[];
    cg::grid_group grid = cg::this_grid();
    LAS unsigned char* ldsl = (LAS unsigned char*)lds;
    const int tid = threadIdx.x, lane = tid & 63, wave = __builtin_amdgcn_readfirstlane(tid >> 6);
    const int G = gridDim.x, bx = blockIdx.x;
    const int vcu = (G % 8 == 0) ? (bx % 8) * (G / 8) + bx / 8 : bx;
    unsigned char* ws = args.ws;
    const float* x = args.in[0]; const float* w_in = args.in[1]; const float* w_out = args.in[2];
    const float* g1 = args.in[3]; const float* g2 = args.in[4]; const float* gf = args.in[5]; const float* subg = args.in[6];
    const float* lq1 = args.in[7]; const float* lk1 = args.in[8]; const float* lq2 = args.in[9]; const float* lk2 = args.in[10];
    const float* relb = args.in[11]; const float* w_ff1 = args.in[12]; const float* w_ff2 = args.in[13];
    float* out = args.out;
    bf16* Win_t = (bf16*)(ws + WS_WIN); bf16* Wo_t = (bf16*)(ws + WS_WO); bf16* W1_t = (bf16*)(ws + WS_W1); bf16* W2_t = (bf16*)(ws + WS_W2);
    bf16* XB = (bf16*)(ws + WS_XB); bf16* PROJ = (bf16*)(ws + WS_PROJ); bf16* MIX = (bf16*)(ws + WS_MIX); bf16* HB = (bf16*)(ws + WS_H);
    float* ROPE = (float*)(ws + WS_ROPE); float* BT = (float*)(ws + WS_BT); float* SS2 = (float*)(ws + WS_SS2); float* SS3 = (float*)(ws + WS_SS3);

    {
        LAS float* scr = (LAS float*)(ldsl + wave * 16384);
        const int gw = vcu * NWAVES + wave, NGW = G * NWAVES;
        constexpr int I_IN = (D / 64) * (NIN / 32), I_O = (D / 64) * (D / 32), I_1 = (D / 64) * (FF / 32), I_2 = (FF / 64) * (D / 32);
        constexpr int NITEMS = I_IN + I_O + I_1 + I_2;
        for (int it = gw; it < NITEMS; it += NGW) {
            int r = it;
            if (r < I_IN) { p0_transpose_item(w_in, g1, D, NIN, Win_t, scr, r, lane); continue; } r -= I_IN;
            if (r < I_O) { p0_transpose_item(w_out, nullptr, D, D, Wo_t, scr, r, lane); continue; } r -= I_O;
            if (r < I_1) { p0_transpose_item(w_ff1, g2, D, FF, W1_t, scr, r, lane); continue; } r -= I_1;
            p0_transpose_item(w_ff2, nullptr, FF, D, W2_t, scr, r, lane);
        }
        for (int m = gw; m < M; m += NGW) {
            const f32x4* xr = (const f32x4*)(x + (size_t)m * D) + lane;
            f32x4 v[4]; float s2 = 0.f;
#pragma unroll
            for (int j = 0; j < 4; ++j) { v[j] = xr[64 * j]; s2 += (v[j].x * v[j].x + v[j].y * v[j].y) + (v[j].z * v[j].z + v[j].w * v[j].w); }
            const float rstd = 1.f / sqrtf(wave_sum(s2) * (1.f / D) + EPS);
            unsigned long long* o8 = (unsigned long long*)(XB + (size_t)m * D) + lane;
#pragma unroll
            for (int j = 0; j < 4; ++j) o8[64 * j] = (unsigned long long)pk2(v[j].x * rstd, v[j].y * rstd) | ((unsigned long long)pk2(v[j].z * rstd, v[j].w * rstd) << 32);
        }
        const int gt = vcu * (NWAVES * 64) + tid, NGT = G * NWAVES * 64;
        for (int e = gt; e < SEQ * 16; e += NGT) {
            const int pos = e >> 4, i = e & 15;
            const float invf = __builtin_amdgcn_exp2f(-(float)i * (13.287712379549449f / 16.0f));
            const double rev = (double)pos * (double)invf * 0.15915494309189535;
            const float fr = (float)(rev - (double)(long long)rev);
            ROPE[2 * e] = __builtin_amdgcn_cosf(fr); ROPE[2 * e + 1] = __builtin_amdgcn_sinf(fr);
        }
        for (int e = gt; e < 8 * 384; e += NGT) {
            const int hh = e / 384, k = e % 384; int dd = k - 63; dd = dd > 256 ? 256 : dd;
            BT[e] = relb[hh * 513 + dd + 256] * 1.4426950408889634f;
        }
    }
    grid.sync();
    if (PH_LIMIT <= 1) return;
    {
        pg8::Gemm g{XB, Win_t, M, NIN, D}; pg8::StaticOrder S; S.init(M, NIN, G, bx);
        pg8::EpiQKV E{PROJ, ROPE};
        pg8::gemm_phase<pg8::EpiQKV, pg8::StaticOrder, true, true>(ldsl, g, S, E);
    }
    grid.sync();
    if (PH_LIMIT <= 2) return;
    {
        float s1 = 0.f, s2 = 0.f;
        for (int i = 0; i < 32; ++i) { s1 += lq1[i] * lk1[i]; s2 += lq2[i] * lk2[i]; }
        const float lam = __expf(s1) - __expf(s2) + 0.2f;
        for (int v = vcu; v < 256; v += G) {
            const int pair = v >> 1, which = v & 1, b = pair >> 2, hp = pair & 3;
            for (int i = 7; i >= 0; --i) { const int cp = 2 * i + ((i & 1) ^ which); att::attn_unit<true>(b, hp, cp, PROJ, MIX, ldsl, lam, subg, BT); }
            for (int i = 7; i >= 0; --i) { const int cp = 2 * i + ((i & 1) ^ which); att::attn_unit<false>(b, hp, cp, PROJ, MIX, ldsl, lam, subg, BT); }
        }
    }
    grid.sync();
    if (PH_LIMIT <= 3) return;
    {
        pg8::Gemm g{MIX, Wo_t, M, D, D}; pg8::StaticOrder S; S.init(M, D, G, bx);
        pg8::EpiResid E{x, out, XB, SS2};
        pg8::gemm_phase<pg8::EpiResid, pg8::StaticOrder, true, true>(ldsl, g, S, E);
    }
    grid.sync();
    if (PH_LIMIT <= 4) return;
    {
        pg8::Gemm g{XB, W1_t, M, FF, D}; pg8::StaticOrder S; S.init(M, FF, G, bx);
        pg8::EpiUp E{HB, SS2};
        pg8::gemm_phase<pg8::EpiUp, pg8::StaticOrder, true, true>(ldsl, g, S, E);
    }
    grid.sync();
    if (PH_LIMIT <= 5) return;
    {
        pg8::Gemm g{HB, W2_t, M, D, FF}; pg8::StaticOrder S; S.init(M, D, G, bx);
        pg8::EpiResid E{out, out, nullptr, SS3};
        pg8::gemm_phase<pg8::EpiResid, pg8::StaticOrder, true, true>(ldsl, g, S, E);
    }
    grid.sync();
    if (PH_LIMIT <= 6) return;
    {
        const int gw = vcu * NWAVES + wave, NGW = G * NWAVES;
        f32x4 gv[4];
#pragma unroll
        for (int j = 0; j < 4; ++j) gv[j] = ((const f32x4*)gf)[lane + 64 * j];
        for (int m = gw; m < M; m += NGW) {
            const f32x4* sp = (const f32x4*)(SS3 + (size_t)m * 16);
            const f32x4 a = sp[0], b = sp[1], c = sp[2], d = sp[3];
            const float tot = ((a[0] + a[1]) + (a[2] + a[3])) + ((b[0] + b[1]) + (b[2] + b[3])) + ((c[0] + c[1]) + (c[2] + c[3])) + ((d[0] + d[1]) + (d[2] + d[3]));
            const float r = 1.0f / sqrtf(tot * (1.0f / D) + EPS);
            f32x4* xr = (f32x4*)(out + (size_t)m * D) + lane;
#pragma unroll
            for (int j = 0; j < 4; ++j) { const f32x4 v = xr[64 * j]; xr[64 * j] = v * r * gv[j]; }
        }
    }
}

extern "C" void kernel_launch(void* const* d_in, const int* in_sizes, int n_in, void* d_out, int out_size, void* d_ws, size_t ws_size, hipStream_t stream) {
    static int grid = 0;
    if (grid == 0) {
        if (n_in != 14 || in_sizes[0] != M * D || out_size != M * D || ws_size < WS_END) { fprintf(stderr, "kernel_launch: unexpected shapes (n_in %d, in0 %d, out %d, ws %zu); nothing launched\n", n_in, n_in > 0 ? in_sizes[0] : -1, out_size, ws_size); grid = -1; return; }
        int dev = 0, cus = 0, per_cu = 0;
        if (hipGetDevice(&dev) != hipSuccess || hipDeviceGetAttribute(&cus, hipDeviceAttributeMultiprocessorCount, dev) != hipSuccess) { grid = -1; return; }
        (void)hipFuncSetAttribute((const void*)mk_fwd, hipFuncAttributeMaxDynamicSharedMemorySize, LDS_BYTES);
        if (hipOccupancyMaxActiveBlocksPerMultiprocessor(&per_cu, (const void*)mk_fwd, NWAVES * 64, LDS_BYTES) != hipSuccess || per_cu < 1) { fprintf(stderr, "kernel_launch: occupancy query reports %d\n", per_cu); per_cu = 1; }
        (void)hipGetLastError();
        grid = cus * per_cu;
    }
    if (grid < 0) return;
    Args a{};
    for (int i = 0; i < 14; ++i) a.in[i] = (const float*)d_in[i];
    a.out = (float*)d_out; a.ws = (unsigned char*)d_ws;
    void* kargs[] = {&a};
    const hipError_t e = hipLaunchCooperativeKernel((const void*)mk_fwd, dim3(grid), dim3(NWAVES * 64), kargs, LDS_BYTES, stream);
    if (e != hipSuccess) fprintf(stderr, "kernel_launch: cooperative launch failed: %s (grid %d)\n", hipGetErrorString(e), grid);
}
```

```cpp
#include <hip/hip_runtime.h>
#include <hip/hip_cooperative_groups.h>
#include <cstdio>
#include <cstdint>
namespace cg = cooperative_groups;
namespace pg8 {
#define PG8_LAS __attribute__((address_space(3)))
typedef unsigned short bf16_t;
typedef short bf16x8 __attribute__((ext_vector_type(8)));
typedef float f32x4 __attribute__((ext_vector_type(4)));
typedef unsigned u32x4 __attribute__((ext_vector_type(4)));
constexpr int BM = 256, BK = 64, HALF = 128, HTB = HALF * BK * 2  , STAGE_BYTES = 8 * HTB, NXCD = 8, WGM = 8;

__host__ __device__ __forceinline__ int lds_byte(int r, int c) { const int st = (r >> 4) * 2 + (c >> 5), rr = r & 15, cc = c & 31, ob = rr * 64 + cc * 2; return st * 1024 + (ob ^ (((ob >> 9) & 1) << 5)); }
__host__ __device__ __forceinline__ void stage_rc(int b, int& R, int& C) { const int st = b / 1024, sb = b % 1024, swz = sb ^ (((sb >> 9) & 1) << 5); R = (st >> 1) * 16 + swz / 64; C = (st & 1) * 32 + (swz % 64) / 2; }
__host__ __device__ __forceinline__ int perm32(int rho) { const int n = rho >> 4, i = rho & 15; return 8 * (i >> 2) + 4 * n + (i & 3); }

struct Unit { int pm, pn; };
struct Gemm { const bf16_t* A; const bf16_t* Bt; int M, N, K; };

struct StaticOrder {
    int nM, nN, nwg, G, c;
    __host__ __device__ void init(int M, int N, int G_, int c_) { nM = M / BM; nN = N / BM; nwg = nM * nN; G = G_; c = c_; }
    __host__ __device__ bool next(int i, Unit& u) const {
        const long L = (long)i * G + c; if (L >= nwg) return false;
        int wgid = (int)L; { const int q = nwg / NXCD, r = nwg % NXCD, xcd = wgid % NXCD, off = wgid / NXCD; wgid = (xcd < r ? xcd * (q + 1) : r * (q + 1) + (xcd - r) * q) + off; }
        const int nig = WGM * nN, gid = wgid / nig, fm = gid * WGM, gsz = (nM - fm) < WGM ? (nM - fm) : WGM;
        u.pm = fm + ((wgid % nig) % gsz); u.pn = (wgid % nig) / gsz; return true;
    }
    __device__ __forceinline__ void a_ready(const Unit&) const {}
    __device__ __forceinline__ void done(const Unit&) const {}
};

__device__ __forceinline__ unsigned cvt_pk_bf16(float lo, float hi) { unsigned r; asm volatile("v_cvt_pk_bf16_f32 %0, %1, %2" : "=v"(r) : "v"(lo), "v"(hi)); return r; }
constexpr float QSCALE_A = 0.17677669529663687f * 1.4426950408889634f;
constexpr float QSCALE_B = 0.125f * 1.4426950408889634f;
struct EpiQKV {
    static constexpr bool PERM = true, AFTER_DRAIN = false;
    bf16_t* O; const float* rope;
    __device__ __forceinline__ void operator()(const f32x4 (&acc)[2][2][4][2], const Unit& u, int wr, int wc, int fr, int fq) const {
        const int row0 = u.pm * BM + wr * 64 + fr, col0 = u.pn * BM + wc * 32 + 8 * fq;
        const bool do_rope = u.pn < 4;
        const float qs = (u.pn < 2) ? QSCALE_A : ((u.pn == 6 || u.pn == 7) ? QSCALE_B : 1.f);
        const float sgn = (fq < 2) ? -1.f : 1.f;
#pragma unroll
        for (int ai = 0; ai < 2; ++ai)
#pragma unroll
            for (int m = 0; m < 4; ++m) {
                const int row = row0 + ai * HALF + m * 16;
                f32x4 v[2][2];
#pragma unroll
                for (int bj = 0; bj < 2; ++bj)
#pragma unroll
                    for (int n = 0; n < 2; ++n) v[bj][n] = acc[ai][bj][m][n];
                if (do_rope) {
                    const int pos = row & 2047;
                    const f32x4* rp = (const f32x4*)(rope + (size_t)(pos * 16 + 8 * (fq & 1)) * 2);
                    const f32x4 cs0 = rp[0], cs1 = rp[1], cs2 = rp[2], cs3 = rp[3];
                    const f32x4 c0 = {cs0[0], cs0[2], cs1[0], cs1[2]}, s0 = {cs0[1], cs0[3], cs1[1], cs1[3]};
                    const f32x4 c1 = {cs2[0], cs2[2], cs3[0], cs3[2]}, s1 = {cs2[1], cs2[3], cs3[1], cs3[3]};
#pragma unroll
                    for (int bj = 0; bj < 2; ++bj)
#pragma unroll
                        for (int n = 0; n < 2; ++n) {
                            const f32x4 x = v[bj][n]; f32x4 xp;
                            xp[0] = __shfl_xor(x[0], 32); xp[1] = __shfl_xor(x[1], 32); xp[2] = __shfl_xor(x[2], 32); xp[3] = __shfl_xor(x[3], 32);
                            const f32x4 c = n ? c1 : c0, s = n ? s1 : s0;
                            v[bj][n] = x * c + (xp * s) * sgn;
                        }
                }
                bf16_t* rowp = O + (size_t)row * 3072 + col0;
#pragma unroll
                for (int bj = 0; bj < 2; ++bj) { const f32x4 v0 = v[bj][0] * qs, v1 = v[bj][1] * qs;
                    u32x4 w; w.x = cvt_pk_bf16(v0[0], v0[1]); w.y = cvt_pk_bf16(v0[2], v0[3]); w.z = cvt_pk_bf16(v1[0], v1[1]); w.w = cvt_pk_bf16(v1[2], v1[3]);
                    *(u32x4*)(rowp + bj * HALF) = w; }
            }
    }
};
struct EpiResid {
    static constexpr bool PERM = true, AFTER_DRAIN = false;
    const float* base; float* out; bf16_t* ob; float* ss;
    __device__ __forceinline__ void operator()(const f32x4 (&acc)[2][2][4][2], const Unit& u, int wr, int wc, int fr, int fq) const {
        const int row0 = u.pm * BM + wr * 64 + fr, col0 = u.pn * BM + wc * 32 + 8 * fq;
#pragma unroll
        for (int ai = 0; ai < 2; ++ai)
#pragma unroll
            for (int m = 0; m < 4; ++m) {
                const int row = row0 + ai * HALF + m * 16; const size_t off = (size_t)row * 1024 + col0;
                float s = 0.f;
#pragma unroll
                for (int bj = 0; bj < 2; ++bj) {
                    const f32x4 b0 = *(const f32x4*)(base + off + bj * HALF), b1 = *(const f32x4*)(base + off + bj * HALF + 4);
                    const f32x4 v0 = acc[ai][bj][m][0] + b0, v1 = acc[ai][bj][m][1] + b1;
                    *(f32x4*)(out + off + bj * HALF) = v0; *(f32x4*)(out + off + bj * HALF + 4) = v1;
                    if (ob) { u32x4 w; w.x = cvt_pk_bf16(v0[0], v0[1]); w.y = cvt_pk_bf16(v0[2], v0[3]); w.z = cvt_pk_bf16(v1[0], v1[1]); w.w = cvt_pk_bf16(v1[2], v1[3]);
                        *(u32x4*)(ob + off + bj * HALF) = w; }
                    s += (v0[0] * v0[0] + v0[1] * v0[1]) + (v0[2] * v0[2] + v0[3] * v0[3]) + (v1[0] * v1[0] + v1[1] * v1[1]) + (v1[2] * v1[2] + v1[3] * v1[3]);
                }
                s += __shfl_xor(s, 16); s += __shfl_xor(s, 32);
                if (fq == 0) ss[(size_t)row * 16 + u.pn * 4 + wc] = s;
                asm volatile("" ::: "memory");
            }
    }
};
struct EpiUp {
    static constexpr bool PERM = true, AFTER_DRAIN = false;
    bf16_t* O; const float* ss;
    __device__ __forceinline__ void operator()(const f32x4 (&acc)[2][2][4][2], const Unit& u, int wr, int wc, int fr, int fq) const {
        const int row0 = u.pm * BM + wr * 64 + fr, col0 = u.pn * BM + wc * 32 + 8 * fq;
#pragma unroll
        for (int ai = 0; ai < 2; ++ai)
#pragma unroll
            for (int m = 0; m < 4; ++m) {
                const int row = row0 + ai * HALF + m * 16;
                const f32x4* sp = (const f32x4*)(ss + (size_t)row * 16);
                const f32x4 a = sp[0], b = sp[1], c = sp[2], d = sp[3];
                const float tot = ((a[0] + a[1]) + (a[2] + a[3])) + ((b[0] + b[1]) + (b[2] + b[3])) + ((c[0] + c[1]) + (c[2] + c[3])) + ((d[0] + d[1]) + (d[2] + d[3]));
                const float r = 1.0f / sqrtf(tot * (1.0f / 1024.0f) + 1e-6f);
                bf16_t* rowp = O + (size_t)row * 4096 + col0;
#pragma unroll
                for (int bj = 0; bj < 2; ++bj) {
                    f32x4 v0 = acc[ai][bj][m][0] * r, v1 = acc[ai][bj][m][1] * r;
#pragma unroll
                    for (int e = 0; e < 4; ++e) { v0[e] = fmaxf(v0[e], 0.f); v1[e] = fmaxf(v1[e], 0.f); }
                    v0 = v0 * v0; v1 = v1 * v1;
                    u32x4 w; w.x = cvt_pk_bf16(v0[0], v0[1]); w.y = cvt_pk_bf16(v0[2], v0[3]); w.z = cvt_pk_bf16(v1[0], v1[1]); w.w = cvt_pk_bf16(v1[2], v1[3]);
                    *(u32x4*)(rowp + bj * HALF) = w;
                }
            }
    }
};

template <class Epi, class Sched, bool ALIGN_EPI = false, bool SP2 = false>
__device__ __forceinline__ void gemm_phase(PG8_LAS unsigned char* lds, const Gemm g, const Sched& S, const Epi& E) {
    int tid_ = threadIdx.x; asm volatile("" : "+v"(tid_));
    const int tid = tid_, wid = __builtin_amdgcn_readfirstlane(tid >> 6), lane = tid & 63, wr = wid >> 2, wc = wid & 3, fr = lane & 15, fq = lane >> 4;
    const int K = g.K, nt = K / BK;
    unsigned voffA[2], voffB[2];
#pragma unroll
    for (int i = 0; i < 2; ++i) { int R, C; stage_rc(tid * 16 + i * 8192, R, C); const int Rb = Epi::PERM ? ((R & ~31) + perm32(R & 31)) : R;
        voffA[i] = (unsigned)(R * K + C) * 2u; voffB[i] = (unsigned)(Rb * K + C) * 2u; }
    const size_t kstep = (size_t)(BK * 2);
    const size_t hstep = (size_t)HALF * K * 2;
    const size_t tstep = 2 * hstep;
    const unsigned ldsw = (unsigned)wid * 1024u;
    const int aoff = lds_byte(wr * 64 + fr, fq * 8), boff = lds_byte(wc * 32 + fr, fq * 8);
#define PG8_SA(b, h) (((b) * 2 + (h)) * HTB)
#define PG8_SB(b, h) ((4 + (b) * 2 + (h)) * HTB)
#define PG8_STAGE(bufoff, gbase, voff) do { _Pragma("unroll") for (int _i = 0; _i < 2; ++_i) \
        __builtin_amdgcn_global_load_lds((const unsigned*)((const char*)(gbase) + (voff)[_i]), (PG8_LAS unsigned*)(lds + (bufoff) + ldsw + _i * 8192), 16, 0, 0); } while (0)
#define PG8_LDA(dst, b, h) do { _Pragma("unroll") for (int m = 0; m < 4; ++m) _Pragma("unroll") for (int k = 0; k < 2; ++k) dst[m][k] = *(const PG8_LAS bf16x8*)(lds + PG8_SA(b, h) + aoff + m * 2048 + k * 1024); } while (0)
#define PG8_LDB(dst, b, h) do { _Pragma("unroll") for (int n = 0; n < 2; ++n) _Pragma("unroll") for (int k = 0; k < 2; ++k) dst[n][k] = *(const PG8_LAS bf16x8*)(lds + PG8_SB(b, h) + boff + n * 2048 + k * 1024); } while (0)
#define PG8_MMA(ai, bj, At, Bt) do { __builtin_amdgcn_s_setprio(1); _Pragma("unroll") for (int m = 0; m < 4; ++m) _Pragma("unroll") for (int n = 0; n < 2; ++n) _Pragma("unroll") for (int k = 0; k < 2; ++k) \
        acc[ai][bj][m][n] = __builtin_amdgcn_mfma_f32_16x16x32_bf16(Bt[n][k], At[m][k], acc[ai][bj][m][n], 0, 0, 0); __builtin_amdgcn_s_setprio(0); } while (0)
#define PG8_WAIT_V(n) asm volatile("s_waitcnt vmcnt(" #n ")" ::: "memory")
#define PG8_WAIT_L(n) asm volatile("s_waitcnt lgkmcnt(" #n ")" ::: "memory")
#define PG8_BAR __builtin_amdgcn_s_barrier()
#define PG8_SCHED __builtin_amdgcn_sched_barrier(0)
    Unit cur, nxt; int ui = 0;
    if (!S.next(0, cur)) return;
    f32x4 acc[2][2][4][2];
#pragma unroll
    for (int a = 0; a < 2; ++a)
#pragma unroll
        for (int b = 0; b < 2; ++b)
#pragma unroll
            for (int m = 0; m < 4; ++m)
#pragma unroll
                for (int n = 0; n < 2; ++n) acc[a][b][m][n] = (f32x4){0.f, 0.f, 0.f, 0.f};
    bf16x8 At[4][2], B0[2][2], B1[2][2];
    const char* cA = (const char*)g.A + (size_t)cur.pm * tstep; const char* cB = (const char*)g.Bt + (size_t)cur.pn * tstep;
    S.a_ready(cur);
    if constexpr (SP2) {
        PG8_STAGE(PG8_SB(0, 0), cB, voffB); PG8_STAGE(PG8_SB(0, 1), cB + hstep, voffB); PG8_STAGE(PG8_SA(0, 0), cA, voffA); PG8_STAGE(PG8_SA(0, 1), cA + hstep, voffA);
        if (wr == 1) PG8_BAR;
        PG8_WAIT_V(2); PG8_BAR;
        PG8_STAGE(PG8_SB(1, 0), cB + kstep, voffB); PG8_STAGE(PG8_SA(1, 0), cA + kstep, voffA); PG8_STAGE(PG8_SB(1, 1), cB + hstep + kstep, voffB);
        PG8_WAIT_V(6); PG8_BAR;
    } else {
        PG8_STAGE(PG8_SB(0, 0), cB, voffB); PG8_STAGE(PG8_SA(0, 0), cA, voffA); PG8_STAGE(PG8_SB(0, 1), cB + hstep, voffB); PG8_STAGE(PG8_SA(0, 1), cA + hstep, voffA);
        if (wr == 1) PG8_BAR;
        PG8_WAIT_V(4); PG8_BAR;
        PG8_STAGE(PG8_SB(1, 0), cB + kstep, voffB); PG8_STAGE(PG8_SA(1, 0), cA + kstep, voffA); PG8_STAGE(PG8_SB(1, 1), cB + hstep + kstep, voffB);
        PG8_WAIT_V(6); PG8_BAR;
    }
    for (;;) {
        const bool has_next = S.next(ui + 1, nxt);
        const char* nA = has_next ? (const char*)g.A + (size_t)nxt.pm * tstep : cA; const char* nB = has_next ? (const char*)g.Bt + (size_t)nxt.pn * tstep : cB;
        for (int t = 0; t < nt; t += 2) {
            const bool last = (t == nt - 2);
            const char* a1 = cA + (size_t)(t + 1) * kstep;
            const char* a2 = last ? nA : cA + (size_t)(t + 2) * kstep; const char* b2 = last ? nB : cB + (size_t)(t + 2) * kstep;
            const char* a3 = a2 + kstep; const char* b3 = b2 + kstep;
            if (last && has_next) S.a_ready(nxt);
            if constexpr (SP2) {
            PG8_LDB(B0, 0, 0); PG8_LDB(B1, 0, 1); PG8_SCHED; PG8_LDA(At, 0, 0); PG8_STAGE(PG8_SA(1, 1), a1 + hstep, voffA);
            PG8_WAIT_V(8); PG8_WAIT_L(0); PG8_BAR; PG8_MMA(0, 0, At, B0); PG8_MMA(0, 1, At, B1); PG8_BAR; PG8_SCHED;
            PG8_LDA(At, 0, 1); PG8_STAGE(PG8_SB(0, 0), b2, voffB); PG8_STAGE(PG8_SB(0, 1), b2 + hstep, voffB); PG8_STAGE(PG8_SA(0, 0), a2, voffA);
            PG8_WAIT_V(8); PG8_WAIT_L(0); PG8_BAR; PG8_MMA(1, 0, At, B0); PG8_MMA(1, 1, At, B1); PG8_BAR; PG8_SCHED;
            PG8_LDB(B0, 1, 0); PG8_LDB(B1, 1, 1); PG8_SCHED; PG8_LDA(At, 1, 0); PG8_STAGE(PG8_SA(0, 1), a2 + hstep, voffA);
            PG8_WAIT_V(8); PG8_WAIT_L(0); PG8_BAR; PG8_MMA(0, 0, At, B0); PG8_MMA(0, 1, At, B1); PG8_BAR; PG8_SCHED;
            PG8_LDA(At, 1, 1); PG8_STAGE(PG8_SB(1, 0), b3, voffB); PG8_STAGE(PG8_SB(1, 1), b3 + hstep, voffB); PG8_STAGE(PG8_SA(1, 0), a3, voffA);
            PG8_WAIT_V(8); PG8_WAIT_L(0); PG8_BAR; PG8_MMA(1, 0, At, B0); PG8_MMA(1, 1, At, B1); PG8_BAR; PG8_SCHED;
            } else {
            PG8_LDB(B0, 0, 0); PG8_SCHED; PG8_LDA(At, 0, 0); PG8_STAGE(PG8_SA(1, 1), a1 + hstep, voffA);
            PG8_WAIT_L(8); PG8_BAR; PG8_WAIT_L(0); PG8_MMA(0, 0, At, B0); PG8_BAR; PG8_SCHED;
            PG8_LDB(B1, 0, 1); PG8_STAGE(PG8_SB(0, 0), b2, voffB);
            PG8_BAR; PG8_WAIT_L(0); PG8_MMA(0, 1, At, B1); PG8_BAR;
            PG8_LDA(At, 0, 1); PG8_STAGE(PG8_SA(0, 0), a2, voffA);
            PG8_BAR; PG8_WAIT_L(0); PG8_MMA(1, 0, At, B0); PG8_BAR; PG8_SCHED;
            PG8_STAGE(PG8_SB(0, 1), b2 + hstep, voffB);
            PG8_WAIT_V(6); PG8_BAR; PG8_MMA(1, 1, At, B1); PG8_BAR;
            PG8_LDB(B0, 1, 0); PG8_SCHED; PG8_LDA(At, 1, 0); PG8_STAGE(PG8_SA(0, 1), a2 + hstep, voffA);
            PG8_WAIT_L(8); PG8_BAR; PG8_WAIT_L(0); PG8_MMA(0, 0, At, B0); PG8_BAR; PG8_SCHED;
            PG8_LDB(B1, 1, 1); PG8_STAGE(PG8_SB(1, 0), b3, voffB);
            PG8_BAR; PG8_WAIT_L(0); PG8_MMA(0, 1, At, B1); PG8_BAR;
            PG8_LDA(At, 1, 1); PG8_STAGE(PG8_SA(1, 0), a3, voffA);
            PG8_BAR; PG8_WAIT_L(0); PG8_MMA(1, 0, At, B0); PG8_BAR; PG8_SCHED;
            PG8_STAGE(PG8_SB(1, 1), b3 + hstep, voffB);
            PG8_WAIT_V(6); PG8_BAR; PG8_MMA(1, 1, At, B1); PG8_BAR;
            }
        }
        if constexpr (ALIGN_EPI) { if (wr == 0) PG8_BAR; }
        if constexpr (!Epi::AFTER_DRAIN) { E(acc, cur, wr, wc, fr, fq); S.done(cur); }
        if (!has_next) break;
#pragma unroll
        for (int a = 0; a < 2; ++a)
#pragma unroll
            for (int b = 0; b < 2; ++b)
#pragma unroll
                for (int m = 0; m < 4; ++m)
#pragma unroll
                    for (int n = 0; n < 2; ++n) acc[a][b][m][n] = (f32x4){0.f, 0.f, 0.f, 0.f};
        cur = nxt; cA = nA; cB = nB; ++ui;
        if constexpr (ALIGN_EPI) { if (wr == 1) PG8_BAR; }
    }
    PG8_WAIT_V(0);
    if constexpr (!ALIGN_EPI) { if (wr == 0) PG8_BAR; }
    PG8_BAR;
    if constexpr (Epi::AFTER_DRAIN) { E.fused(acc, cur, wr, wc, fr, fq, lds, wid, lane); S.done(cur); }
#undef PG8_SA
#undef PG8_SB
#undef PG8_STAGE
#undef PG8_LDA
#undef PG8_LDB
#undef PG8_MMA
#undef PG8_WAIT_V
#undef PG8_WAIT_L
#undef PG8_BAR
#undef PG8_SCHED
}
}
namespace att {
#define ALAS __attribute__((address_space(3)))
typedef unsigned short bf16;
typedef short bf16x8 __attribute__((ext_vector_type(8)));
typedef short s16x4 __attribute__((ext_vector_type(4)));
typedef float f32x16 __attribute__((ext_vector_type(16)));
typedef unsigned u32x4 __attribute__((ext_vector_type(4)));
constexpr int SEQ = 2048, PITCH = 3072, MIXP = 1024;
constexpr int STAGE = 32768, NSTAGE = 3;
constexpr int LDS_WS = NSTAGE * STAGE, LDS_OST = LDS_WS + 8 * 512, LDS_BIAS = LDS_OST + 8 * 4096, LDS_END = LDS_BIAS + 768 * 4;
constexpr float THR = 8.0f;
__device__ __forceinline__ int crow(int r, int hi) { return (r & 3) + 8 * (r >> 2) + 4 * hi; }
__device__ __forceinline__ void glds16(const void* gsrc, unsigned lds_dst) { unsigned keep;
    asm volatile("s_mov_b32 %0, m0\n\ts_mov_b32 m0, %2\n\ts_nop 0\n\tglobal_load_lds_dwordx4 %1, off\n\ts_mov_b32 m0, %0" : "=&s"(keep) : "v"(gsrc), "s"(lds_dst) : "memory"); }
typedef float f32x2_t __attribute__((ext_vector_type(2))); typedef __bf16 bf16x2_t __attribute__((ext_vector_type(2)));
__device__ __forceinline__ unsigned cvtpk(float lo, float hi) { f32x2_t v = {lo, hi}; bf16x2_t b = __builtin_convertvector(v, bf16x2_t); return __builtin_bit_cast(unsigned, b); }
typedef short v4i16_t __attribute__((ext_vector_type(4)));
__device__ __forceinline__ s16x4 vtr(const ALAS unsigned char* p) { return __builtin_bit_cast(s16x4, __builtin_amdgcn_ds_read_tr16_b64_v4i16((ALAS v4i16_t*)p)); }
#define MX3(a, b, c) __builtin_fmaxf(__builtin_fmaxf((a), (b)), (c))
__device__ __forceinline__ float rowmax(const f32x16& p0, const f32x16& p1) {
    float a = MX3(p0[0], p0[1], p1[0]), b = MX3(p0[2], p0[3], p1[1]); a = MX3(a, p1[2], p1[3]);
#pragma unroll
    for (int r = 4; r < 16; r += 4) { a = MX3(a, p0[r], p0[r + 1]); b = MX3(b, p0[r + 2], p0[r + 3]); a = MX3(a, p1[r], p1[r + 1]); b = MX3(b, p1[r + 2], p1[r + 3]); }
    float rm = __builtin_fmaxf(a, b);
    auto rr = __builtin_amdgcn_permlane32_swap(__float_as_uint(rm), __float_as_uint(rm), false, false);
    return __builtin_fmaxf(__uint_as_float(rr[0]), __uint_as_float(rr[1]));
}
#define LWAIT() asm volatile("s_waitcnt lgkmcnt(0)" ::: "memory")
#define SB() __builtin_amdgcn_sched_barrier(0)
#define RFL(x) ((unsigned)__builtin_amdgcn_readfirstlane((int)(x)))

struct Cursor { int ui, t, t_hi; };
__device__ __forceinline__ void unit_range(int ui, int which, int& cp, int& t_lo, int& t_hi) {
    const int i = 7 - (ui & 7); cp = 2 * i + ((i & 1) ^ which);
    t_lo = (ui < 8) ? 0 : (2 * cp - 8 > 0 ? 2 * cp - 8 : 0); t_hi = 2 * cp + 1;
}
struct Stream {
    const bf16* kbase; const bf16* vbase; unsigned kdst, vdst; int which; Cursor c;
    __device__ __forceinline__ void issue(int st) {
        if (c.ui >= 16) return;
        const long o_ = (long)c.t * 64 * PITCH; const int ck = (c.ui < 8) ? 512 : 2048, cv = (c.ui < 8) ? 1024 : 2560; const unsigned s_ = (unsigned)st * STAGE;
        glds16(kbase + o_ + ck, RFL(kdst + s_)); glds16(kbase + o_ + ck + 64, RFL(kdst + s_ + 16384)); glds16(vbase + o_ + cv, RFL(vdst + s_)); glds16(vbase + o_ + cv + 64, RFL(vdst + s_ + 16384));
        if (c.t < c.t_hi) { ++c.t; } else { ++c.ui; if (c.ui < 16) { int cp, lo, hi_; unit_range(c.ui, which, cp, lo, hi_); c.t = lo; c.t_hi = hi_; } }
    }
};

#define EXPCH(P, B, PW, MH, SA, SB_) do { \
    P[B] = __builtin_amdgcn_exp2f(P[B] - MH); P[B + 1] = __builtin_amdgcn_exp2f(P[B + 1] - MH); P[B + 2] = __builtin_amdgcn_exp2f(P[B + 2] - MH); P[B + 3] = __builtin_amdgcn_exp2f(P[B + 3] - MH); \
    P[B + 4] = __builtin_amdgcn_exp2f(P[B + 4] - MH); P[B + 5] = __builtin_amdgcn_exp2f(P[B + 5] - MH); P[B + 6] = __builtin_amdgcn_exp2f(P[B + 6] - MH); P[B + 7] = __builtin_amdgcn_exp2f(P[B + 7] - MH); \
    SA += P[B] + P[B + 1]; SB_ += P[B + 2] + P[B + 3]; SA += P[B + 4] + P[B + 5]; SB_ += P[B + 6] + P[B + 7]; \
    PW = (u32x4){cvtpk(P[B], P[B + 1]), cvtpk(P[B + 2], P[B + 3]), cvtpk(P[B + 4], P[B + 5]), cvtpk(P[B + 6], P[B + 7])}; } while (0)
#define PVK(O, PW, K) do { O[0] = __builtin_amdgcn_mfma_f32_32x32x16_bf16(__builtin_bit_cast(bf16x8, PW), vf[K], O[0], 0, 0, 0); \
                           O[1] = __builtin_amdgcn_mfma_f32_32x32x16_bf16(__builtin_bit_cast(bf16x8, PW), vf[4 + K], O[1], 0, 0, 0); } while (0)

template <bool DIFF>
__device__ __forceinline__ void attn_unit(int ui, int b, int hp, int which, Stream& S, int& stage, bf16x8 (&qn)[4], const bf16* __restrict__ PROJ, bf16* __restrict__ MIX,
                                          ALAS unsigned char* shm, float lam, const float* __restrict__ subg, float bfar) {
    constexpr int NM = DIFF ? 2 : 1;
    int tid_ = threadIdx.x; asm volatile("" : "+v"(tid_));
    const int tid = tid_, lane = tid & 63, r32 = lane & 31, hi = lane >> 5; const int wid = __builtin_amdgcn_readfirstlane(tid >> 6);
    const int hsel = wid >> 2, csel = (wid >> 1) & 1, half = wid & 1;
    int cp, t_lo, t_hi; unit_range(ui, which, cp, t_lo, t_hi);
    const int h = 2 * hp + hsel, chunk = 2 * cp + csel;
    const long rowbase = (long)b * SEQ;
    const int my_lo = DIFF ? 0 : (chunk - 8 > 0 ? chunk - 8 : 0), my_hi = chunk;
    ALAS float* wsf = (ALAS float*)(shm + LDS_WS) + wid * 128;
    ALAS float* bl = (ALAS float*)(shm + LDS_BIAS);
    bf16x8 qr[4];
#pragma unroll
    for (int d0 = 0; d0 < 4; ++d0) qr[d0] = qn[d0];
    float mhat[NM], lsum[NM]; f32x16 o[NM][2];
#pragma unroll
    for (int mp = 0; mp < NM; ++mp) { mhat[mp] = 0.f; lsum[mp] = 0.f; o[mp][0] = f32x16{}; o[mp][1] = f32x16{}; }
    bool first = true;
    for (int t = t_lo; t <= t_hi; ++t) {
        if (ui == 15 && t == t_hi) asm volatile("s_waitcnt vmcnt(0) lgkmcnt(0)\n\ts_barrier" ::: "memory");
        else if (t == t_lo) asm volatile("s_waitcnt vmcnt(8) lgkmcnt(0)\n\ts_barrier" ::: "memory");
        else asm volatile("s_waitcnt vmcnt(4) lgkmcnt(0)\n\ts_barrier" ::: "memory");
        { int s2 = stage + 2; if (s2 >= NSTAGE) s2 -= NSTAGE; S.issue(s2); }
        if (t >= my_lo && t <= my_hi) {
            const ALAS unsigned char* kb = shm + stage * STAGE + hsel * 16384 + hi * 1024 + r32 * 16;
            const ALAS unsigned char* vp = shm + stage * STAGE + hsel * 16384 + 8192 + ((lane >> 4) & 1) * 32 + (lane & 3) * 8 + (4 * hi + ((lane & 15) >> 2)) * 64;
            bf16x8 kf[8];
#pragma unroll
            for (int d0 = 0; d0 < 4; ++d0) { kf[2 * d0] = *(const ALAS bf16x8*)(kb + d0 * 2048); kf[2 * d0 + 1] = *(const ALAS bf16x8*)(kb + d0 * 2048 + 512); }
            f32x16 p[NM][2];
#pragma unroll
            for (int mp = 0; mp < NM; ++mp) { p[mp][0] = f32x16{}; p[mp][1] = f32x16{}; }
#pragma unroll
            for (int d0 = 0; d0 < 4; ++d0) { constexpr int dummy = 0; (void)dummy; const int mp = DIFF ? (d0 >> 1) : 0;
                p[mp][0] = __builtin_amdgcn_mfma_f32_32x32x16_bf16(kf[2 * d0], qr[d0], p[mp][0], 0, 0, 0); p[mp][1] = __builtin_amdgcn_mfma_f32_32x32x16_bf16(kf[2 * d0 + 1], qr[d0], p[mp][1], 0, 0, 0); }
            bf16x8 vf[8];
#pragma unroll
            for (int i = 0; i < 8; ++i) { const s16x4 lo = vtr(vp + (i >> 2) * 4096 + (i & 3) * 1024), hi4 = vtr(vp + (i >> 2) * 4096 + (i & 3) * 1024 + 512);
                vf[i] = (bf16x8){lo[0], lo[1], lo[2], lo[3], hi4[0], hi4[1], hi4[2], hi4[3]}; }
            if (!DIFF) {
                const int dch = chunk - t;
                if (dch <= 4) { const ALAS float* bp = bl + hsel * 384 + 63 + 64 * dch + half * 32 + r32 - 4 * hi;
#pragma unroll
                    for (int r = 0; r < 16; ++r) { const int cr = (r & 3) + 8 * (r >> 2); p[0][0][r] += bp[-cr]; p[0][1][r] += bp[-cr - 32]; } }
                else {
#pragma unroll
                    for (int r = 0; r < 16; ++r) { p[0][0][r] += bfar; p[0][1][r] += bfar; } }
            }
#pragma unroll
            for (int mp = 0; mp < NM; ++mp) {
                const float rm = rowmax(p[mp][0], p[mp][1]) - mhat[mp];
                const bool trig = first || (__any(rm > THR) != 0);
                if (trig) {
                    const float dl = first ? rm : __builtin_fmaxf(rm, 0.f);
                    mhat[mp] += dl;
                    if (!first) { const float f = __builtin_amdgcn_exp2f(-dl); lsum[mp] *= f; if (hi == 0) wsf[r32] = f; LWAIT();
#pragma unroll
                        for (int r = 0; r < 16; ++r) { const float fr_ = wsf[crow(r, hi)]; o[mp][0][r] *= fr_; o[mp][1][r] *= fr_; }
                        LWAIT(); }
                }
            }
            SB();
            u32x4 pw0, pw1, pw2, pw3;
            { const float mh = mhat[0]; float sa = 0.f, sb = 0.f;
              EXPCH(p[0][0], 0, pw0, mh, sa, sb); SB();
              PVK(o[0], pw0, 0); EXPCH(p[0][0], 8, pw1, mh, sa, sb); SB();
              PVK(o[0], pw1, 1); EXPCH(p[0][1], 0, pw2, mh, sa, sb); SB();
              PVK(o[0], pw2, 2); EXPCH(p[0][1], 8, pw3, mh, sa, sb); SB();
              lsum[0] += sa + sb; }
            if (DIFF) {
              u32x4 qw0, qw1, qw2, qw3;
              const float mh = mhat[NM - 1]; float sa = 0.f, sb = 0.f;
              PVK(o[0], pw3, 3); EXPCH(p[NM - 1][0], 0, qw0, mh, sa, sb); SB();
              PVK(o[NM - 1], qw0, 0); EXPCH(p[NM - 1][0], 8, qw1, mh, sa, sb); SB();
              PVK(o[NM - 1], qw1, 1); EXPCH(p[NM - 1][1], 0, qw2, mh, sa, sb); SB();
              PVK(o[NM - 1], qw2, 2); EXPCH(p[NM - 1][1], 8, qw3, mh, sa, sb); SB();
              PVK(o[NM - 1], qw3, 3);
              lsum[NM - 1] += sa + sb;
            } else { PVK(o[0], pw3, 3); }
            SB();
            first = false;
        }
        stage = (stage + 1 == NSTAGE) ? 0 : stage + 1;
    }
    if (ui < 15) {
        int cpn, lo_, hi_; unit_range(ui + 1, which, cpn, lo_, hi_);
        const bf16* Qn = PROJ + (rowbase + (2 * cpn + csel) * 64 + half * 32 + r32) * PITCH + ((ui + 1 < 8) ? 0 : 1536) + h * 64;
#pragma unroll
        for (int d0 = 0; d0 < 4; ++d0) qn[d0] = *(const bf16x8*)(Qn + d0 * 16 + hi * 8);
    }
#pragma unroll
    for (int mp = 0; mp < NM; ++mp) { auto rr = __builtin_amdgcn_permlane32_swap(__float_as_uint(lsum[mp]), __float_as_uint(lsum[mp]), false, false);
        const float l = __uint_as_float(rr[0]) + __uint_as_float(rr[1]); if (hi == 0) wsf[32 + 32 * mp + r32] = 1.0f / l; }
    LWAIT();
    f32x16 of[2];
#pragma unroll
    for (int r = 0; r < 16; ++r) { const float rl0 = wsf[32 + crow(r, hi)];
        if (DIFF) { const float rl1 = wsf[64 + crow(r, hi)] * lam; of[0][r] = o[0][0][r] * rl0 - o[NM - 1][0][r] * rl1; of[1][r] = o[0][1][r] * rl0 - o[NM - 1][1][r] * rl1; }
        else { of[0][r] = o[0][0][r] * rl0; of[1][r] = o[0][1][r] * rl0; } }
    if (DIFF) {
        const float g0 = subg[r32], g1 = subg[32 + r32];
#pragma unroll
        for (int r = 0; r < 16; ++r) { float ss = of[0][r] * of[0][r] + of[1][r] * of[1][r];
            ss += __shfl_xor(ss, 1); ss += __shfl_xor(ss, 2); ss += __shfl_xor(ss, 4); ss += __shfl_xor(ss, 8); ss += __shfl_xor(ss, 16);
            const float sc = 0.8f / sqrtf(ss * (1.0f / 64.0f) + 1e-6f);
            of[0][r] *= sc * g0; of[1][r] *= sc * g1; }
    }
    { ALAS bf16* stg = (ALAS bf16*)(shm + LDS_OST) + wid * 2048;
#pragma unroll
        for (int r = 0; r < 16; ++r) { const int orow = crow(r, hi);
            stg[orow * 64 + r32] = (bf16)(cvtpk(of[0][r], 0.f) & 0xffffu); stg[orow * 64 + 32 + r32] = (bf16)(cvtpk(of[1][r], 0.f) & 0xffffu); }
        LWAIT();
        bf16* Ow = MIX + (rowbase + chunk * 64 + half * 32) * MIXP + (DIFF ? 0 : 512) + h * 64;
#pragma unroll
        for (int i = 0; i < 4; ++i) { const int row = i * 8 + (lane >> 3), ch = lane & 7; const u32x4 v = *(const ALAS u32x4*)(stg + row * 64 + ch * 8); *(u32x4*)(Ow + (long)row * MIXP + ch * 8) = v; }
        LWAIT(); }
}

__device__ __forceinline__ void attn_stream(int v, const bf16* __restrict__ PROJ, bf16* __restrict__ MIX, ALAS unsigned char* shm, float lam, const float* __restrict__ subg, const float* __restrict__ BT) {
    int tid_ = threadIdx.x; asm volatile("" : "+v"(tid_));
    const int tid = tid_, lane = tid & 63, r32 = lane & 31, hi = lane >> 5; const int wid = __builtin_amdgcn_readfirstlane(tid >> 6);
    const int pair = v >> 1, which = v & 1, b = pair >> 2, hp = pair & 3;
    const int hsel = wid >> 2, csel = (wid >> 1) & 1, half = wid & 1;
    const long rowbase = (long)b * SEQ; const unsigned lds0 = (unsigned)(uintptr_t)shm;
    asm volatile("s_waitcnt vmcnt(0) lgkmcnt(0)\n\ts_barrier" ::: "memory");
    ALAS float* bl = (ALAS float*)(shm + LDS_BIAS);
    for (int i = tid; i < 768; i += 512) bl[i] = BT[(2 * hp) * 384 + i];
    const float bfar = BT[(2 * hp + hsel) * 384 + 383];
    Stream S; S.which = which;
    S.kbase = PROJ + (rowbase + lane) * PITCH + hp * 128 + wid * 8;
    S.vbase = PROJ + (rowbase + 16 * (wid & 3) + (lane >> 2)) * PITCH + hp * 128 + (wid >> 2) * 32 + (lane & 3) * 8;
    S.kdst = lds0 + wid * 1024; S.vdst = lds0 + 8192 + wid * 1024;
    { int cp, lo, hi_; unit_range(0, which, cp, lo, hi_); S.c.ui = 0; S.c.t = lo; S.c.t_hi = hi_; }
    S.issue(0); S.issue(1);
    bf16x8 qn[4];
    { int cp, lo, hi_; unit_range(0, which, cp, lo, hi_);
      const bf16* Qn = PROJ + (rowbase + (2 * cp + csel) * 64 + half * 32 + r32) * PITCH + (2 * hp + hsel) * 64;
#pragma unroll
      for (int d0 = 0; d0 < 4; ++d0) qn[d0] = *(const bf16x8*)(Qn + d0 * 16 + hi * 8); }
    int stage = 0;
    for (int ui = 0; ui < 8; ++ui) attn_unit<true>(ui, b, hp, which, S, stage, qn, PROJ, MIX, shm, lam, subg, bfar);
    for (int ui = 8; ui < 16; ++ui) attn_unit<false>(ui, b, hp, which, S, stage, qn, PROJ, MIX, shm, lam, subg, bfar);
}
#undef MX3
#undef LWAIT
#undef SB
#undef RFL
#undef EXPCH
#undef PVK
}

constexpr int NWAVES = 8;
constexpr int BATCH = 32, SEQ = 2048, D = 1024, FF = 4096, NIN = 3072;
constexpr int M = BATCH * SEQ;
constexpr float EPS = 1e-6f;
constexpr size_t MiB = 1u << 20;
constexpr size_t WS_ROPE = 1 * MiB, WS_BT = 1 * MiB + 512 * 1024;
constexpr size_t WS_WIN = 2 * MiB, WS_WO = 8 * MiB, WS_W1 = 10 * MiB, WS_W2 = 18 * MiB;
constexpr size_t WS_SS2 = 28 * MiB, WS_SS3 = 32 * MiB;
constexpr size_t WS_XB = 64 * MiB;
constexpr size_t WS_PROJ = 192 * MiB, WS_MIX = 576 * MiB, WS_H = 192 * MiB, WS_END = 704 * MiB;
constexpr int LDS_BYTES = 147456;
static_assert(att::LDS_END <= LDS_BYTES && pg8::STAGE_BYTES <= LDS_BYTES, "LDS map");

#define GAS __attribute__((address_space(1)))
#define LAS __attribute__((address_space(3)))
typedef unsigned short bf16;
typedef unsigned v4u __attribute__((ext_vector_type(4)));
typedef float f32x4 __attribute__((ext_vector_type(4)));
__device__ __forceinline__ unsigned f2bf(float f) { unsigned u = __builtin_bit_cast(unsigned, f); return (u + 0x7fffu + ((u >> 16) & 1u)) >> 16; }
__device__ __forceinline__ unsigned pk2(float lo, float hi) { return f2bf(lo) | (f2bf(hi) << 16); }
__device__ __forceinline__ float wave_sum(float v) {
#pragma unroll
    for (int o = 1; o < 64; o <<= 1) v += __shfl_xor(v, o);
    return v;
}
__device__ __forceinline__ void p0_transpose_item(const float* W, const float* gain, int K, int N, bf16* WT, LAS float* scr, int item, int lane) {
    const int nblk = N / 32, kb = item / nblk, nb = item % nblk, k0 = 64 * kb, n0 = 32 * nb;
#pragma unroll 8
    for (int i = 0; i < 32; ++i) { const int kk = 2 * i + (lane >> 5); const float g = gain ? gain[k0 + kk] : 1.f; scr[kk * 33 + (lane & 31)] = W[(size_t)(k0 + kk) * N + n0 + (lane & 31)] * g; }
    asm volatile("s_waitcnt lgkmcnt(0)" ::: "memory");
    const int c = lane & 7;
#pragma unroll
    for (int j = 0; j < 4; ++j) { const int n = (lane >> 3) + 8 * j; const LAS float* s = scr + (8 * c) * 33 + n;
        v4u o; o.x = pk2(s[0 * 33], s[1 * 33]); o.y = pk2(s[2 * 33], s[3 * 33]); o.z = pk2(s[4 * 33], s[5 * 33]); o.w = pk2(s[6 * 33], s[7 * 33]);
        *(v4u*)(WT + (size_t)(n0 + n) * K + k0 + 8 * c) = o; }
    asm volatile("s_waitcnt lgkmcnt(0)" ::: "memory");
}

struct Args { const float* in[14]; float* out; unsigned char* ws; };
#ifndef PH_LIMIT
#define PH_LIMIT 7
#endif
__global__ void __launch_bounds__(NWAVES * 64, 2) mk_fwd(Args args) {
    extern __shared__ __attribute__((aligned(16))) unsigned char lds[];
    cg::grid_group grid = cg::this_grid();
    LAS unsigned char* ldsl = (LAS unsigned char*)lds;
    const int tid = threadIdx.x, lane = tid & 63, wave = __builtin_amdgcn_readfirstlane(tid >> 6);
    const int G = gridDim.x, bx = blockIdx.x;
    const int vcu = (G % 8 == 0) ? (bx % 8) * (G / 8) + bx / 8 : bx;
    unsigned char* ws = args.ws;
    const float* x = args.in[0]; const float* w_in = args.in[1]; const float* w_out = args.in[2];
    const float* g1 = args.in[3]; const float* g2 = args.in[4]; const float* gf = args.in[5]; const float* subg = args.in[6];
    const float* lq1 = args.in[7]; const float* lk1 = args.in[8]; const float* lq2 = args.in[9]; const float* lk2 = args.in[10];
    const float* relb = args.in[11]; const float* w_ff1 = args.in[12]; const float* w_ff2 = args.in[13];
    float* out = args.out;
    bf16* Win_t = (bf16*)(ws + WS_WIN); bf16* Wo_t = (bf16*)(ws + WS_WO); bf16* W1_t = (bf16*)(ws + WS_W1); bf16* W2_t = (bf16*)(ws + WS_W2);
    bf16* XB = (bf16*)(ws + WS_XB); bf16* PROJ = (bf16*)(ws + WS_PROJ); bf16* MIX = (bf16*)(ws + WS_MIX); bf16* HB = (bf16*)(ws + WS_H);
    float* ROPE = (float*)(ws + WS_ROPE); float* BT = (float*)(ws + WS_BT); float* SS2 = (float*)(ws + WS_SS2); float* SS3 = (float*)(ws + WS_SS3);

    {
        LAS float* scr = (LAS float*)(ldsl + wave * 16384);
        const int gw = vcu * NWAVES + wave, NGW = G * NWAVES;
        constexpr int I_IN = (D / 64) * (NIN / 32), I_O = (D / 64) * (D / 32), I_1 = (D / 64) * (FF / 32), I_2 = (FF / 64) * (D / 32);
        constexpr int NITEMS = I_IN + I_O + I_1 + I_2;
        for (int it = gw; it < NITEMS; it += NGW) {
            int r = it;
            if (r < I_IN) { p0_transpose_item(w_in, g1, D, NIN, Win_t, scr, r, lane); continue; } r -= I_IN;
            if (r < I_O) { p0_transpose_item(w_out, nullptr, D, D, Wo_t, scr, r, lane); continue; } r -= I_O;
            if (r < I_1) { p0_transpose_item(w_ff1, g2, D, FF, W1_t, scr, r, lane); continue; } r -= I_1;
            p0_transpose_item(w_ff2, nullptr, FF, D, W2_t, scr, r, lane);
        }
        for (int m = gw; m < M; m += NGW) {
            const f32x4* xr = (const f32x4*)(x + (size_t)m * D) + lane;
            f32x4 v[4]; float s2 = 0.f;
#pragma unroll
            for (int j = 0; j < 4; ++j) { v[j] = xr[64 * j]; s2 += (v[j].x * v[j].x + v[j].y * v[j].y) + (v[j].z * v[j].z + v[j].w * v[j].w); }
            const float rstd = 1.f / sqrtf(wave_sum(s2) * (1.f / D) + EPS);
            unsigned long long* o8 = (unsigned long long*)(XB + (size_t)m * D) + lane;
#pragma unroll
            for (int j = 0; j < 4; ++j) o8[64 * j] = (unsigned long long)pk2(v[j].x * rstd, v[j].y * rstd) | ((unsigned long long)pk2(v[j].z * rstd, v[j].w * rstd) << 32);
        }
        const int gt = vcu * (NWAVES * 64) + tid, NGT = G * NWAVES * 64;
        for (int e = gt; e < SEQ * 16; e += NGT) {
            const int pos = e >> 4, i = e & 15;
            const float invf = __builtin_amdgcn_exp2f(-(float)i * (13.287712379549449f / 16.0f));
            const double rev = (double)pos * (double)invf * 0.15915494309189535;
            const float fr = (float)(rev - (double)(long long)rev);
            ROPE[2 * e] = __builtin_amdgcn_cosf(fr); ROPE[2 * e + 1] = __builtin_amdgcn_sinf(fr);
        }
        for (int e = gt; e < 8 * 384; e += NGT) {
            const int hh = e / 384, k = e % 384; int dd = k - 63; dd = dd > 256 ? 256 : dd;
            BT[e] = relb[hh * 513 + dd + 256] * 1.4426950408889634f;
        }
    }
    grid.sync();
    if (PH_LIMIT <= 1) return;
    {
        pg8::Gemm g{XB, Win_t, M, NIN, D}; pg8::StaticOrder S; S.init(M, NIN, G, bx);
        pg8::EpiQKV E{PROJ, ROPE};
        pg8::gemm_phase<pg8::EpiQKV, pg8::StaticOrder, true, true>(ldsl, g, S, E);
    }
    grid.sync();
    if (PH_LIMIT <= 2) return;
    {
        float s1 = 0.f, s2 = 0.f;
        for (int i = 0; i < 32; ++i) { s1 += lq1[i] * lk1[i]; s2 += lq2[i] * lk2[i]; }
        const float lam = __expf(s1) - __expf(s2) + 0.2f;
        for (int v = vcu; v < 256; v += G) att::attn_stream(v, PROJ, MIX, ldsl, lam, subg, BT);
    }
    grid.sync();
    if (PH_LIMIT <= 3) return;
    {
        pg8::Gemm g{MIX, Wo_t, M, D, D}; pg8::StaticOrder S; S.init(M, D, G, bx);
        pg8::EpiResid E{x, out, XB, SS2};
        pg8::gemm_phase<pg8::EpiResid, pg8::StaticOrder, true, true>(ldsl, g, S, E);
    }
    grid.sync();
    if (PH_LIMIT <= 4) return;
    {
        pg8::Gemm g{XB, W1_t, M, FF, D}; pg8::StaticOrder S; S.init(M, FF, G, bx);
        pg8::EpiUp E{HB, SS2};
        pg8::gemm_phase<pg8::EpiUp, pg8::StaticOrder, true, true>(ldsl, g, S, E);
    }
    grid.sync();
    if (PH_LIMIT <= 5) return;
    {
        pg8::Gemm g{HB, W2_t, M, D, FF}; pg8::StaticOrder S; S.init(M, D, G, bx);
        pg8::EpiResid E{out, out, nullptr, SS3};
        pg8::gemm_phase<pg8::EpiResid, pg8::StaticOrder, true, true>(ldsl, g, S, E);
    }
    grid.sync();
    if (PH_LIMIT <= 6) return;
    {
        const int gw = vcu * NWAVES + wave, NGW = G * NWAVES;
        f32x4 gv[4];
#pragma unroll
        for (int j = 0; j < 4; ++j) gv[j] = ((const f32x4*)gf)[lane + 64 * j];
        for (int m = gw; m < M; m += NGW) {
            const f32x4* sp = (const f32x4*)(SS3 + (size_t)m * 16);
            const f32x4 a = sp[0], b = sp[1], c = sp[2], d = sp[3];
            const float tot = ((a[0] + a[1]) + (a[2] + a[3])) + ((b[0] + b[1]) + (b[2] + b[3])) + ((c[0] + c[1]) + (c[2] + c[3])) + ((d[0] + d[1]) + (d[2] + d[3]));
            const float r = 1.0f / sqrtf(tot * (1.0f / D) + EPS);
            f32x4* xr = (f32x4*)(out + (size_t)m * D) + lane;
#pragma unroll
            for (int j = 0; j < 4; ++j) { const f32x4 v = xr[64 * j]; xr[64 * j] = v * r * gv[j]; }
        }
    }
}

extern "C" void kernel_launch(void* const* d_in, const int* in_sizes, int n_in, void* d_out, int out_size, void* d_ws, size_t ws_size, hipStream_t stream) {
    static int grid = 0;
    if (grid == 0) {
        if (n_in != 14 || in_sizes[0] != M * D || out_size != M * D || ws_size < WS_END) { fprintf(stderr, "kernel_launch: unexpected shapes (n_in %d, in0 %d, out %d, ws %zu); nothing launched\n", n_in, n_in > 0 ? in_sizes[0] : -1, out_size, ws_size); grid = -1; return; }
        int dev = 0, cus = 0, per_cu = 0;
        if (hipGetDevice(&dev) != hipSuccess || hipDeviceGetAttribute(&cus, hipDeviceAttributeMultiprocessorCount, dev) != hipSuccess) { grid = -1; return; }
        (void)hipFuncSetAttribute((const void*)mk_fwd, hipFuncAttributeMaxDynamicSharedMemorySize, LDS_BYTES);
        if (hipOccupancyMaxActiveBlocksPerMultiprocessor(&per_cu, (const void*)mk_fwd, NWAVES * 64, LDS_BYTES) != hipSuccess || per_cu < 1) { fprintf(stderr, "kernel_launch: occupancy query reports %d\n", per_cu); per_cu = 1; }
        (void)hipGetLastError();
        grid = cus * per_cu;
    }
    if (grid < 0) return;
    Args a{};
    for (int i = 0; i < 14; ++i) a.in[i] = (const float*)d_in[i];
    a.out = (float*)d_out; a.ws = (unsigned char*)d_ws;
    void* kargs[] = {&a};
    const hipError_t e = hipLaunchCooperativeKernel((const void*)mk_fwd, dim3(grid), dim3(NWAVES * 64), kargs, LDS_BYTES, stream);
    if (e != hipSuccess) fprintf(stderr, "kernel_launch: cooperative launch failed: %s (grid %d)\n", hipGetErrorString(e), grid);
}
```
